# Optimizing an MI355X kernel written in HIP

```python
import jax, jax.numpy as jnp
from jax import lax
import numpy as np

D_MODEL = 1024
BATCH = 4
SEQ = 4096
DEPTH = 2

GRID_W = 64
CTX_LEN = 256
N_EVEN = (DEPTH + 1) // 2
N_ODD = DEPTH // 2
N_MOD = 9
D_FF = 2816
EPS = 1e-6
CONV_DIM = D_MODEL // 2
CONV_WIDTH = 31
CONV_PAD = (CONV_WIDTH - 1) // 2
HEAD_DIM = 64
ATT_HEADS = 8
ATT_KV_HEADS = 2
ATT_GROUP = ATT_HEADS // ATT_KV_HEADS
ATT_DIM = ATT_HEADS * HEAD_DIM
KV_DIM = ATT_KV_HEADS * HEAD_DIM
WINDOW = 128
BLOCK = 128
ROPE_BASE = 10000.0
ROPE_FREQS = HEAD_DIM // 4
Q_OFF = 2 * CONV_DIM
K_OFF = Q_OFF + ATT_DIM
V_OFF = K_OFF + KV_DIM
EVEN_IN = V_OFF + KV_DIM
EVEN_MIX = CONV_DIM + ATT_DIM
ML_HEADS = 4
ML_HEAD_DIM = D_MODEL // ML_HEADS
ML_DIM = ML_HEADS * ML_HEAD_DIM
ML_CHUNK = 128
ODD_IN = 4 * ML_DIM + 4 * ML_HEADS
FORGET_BIAS = 3.0

kernel_name = "hybrid_conv_swa_mlstm_dit_prefix"


def rmsnorm(x, g):
    xf = x.astype(jnp.float32)
    y = xf * lax.rsqrt(jnp.mean(xf * xf, axis=-1, keepdims=True) + EPS)
    return (y * g.astype(jnp.float32)).astype(x.dtype)


def layernorm(x, g, b):
    xf = x.astype(jnp.float32)
    mu = jnp.mean(xf, axis=-1, keepdims=True)
    var = jnp.mean(jnp.square(xf - mu), axis=-1, keepdims=True)
    return ((xf - mu) * lax.rsqrt(var + EPS) * g.astype(jnp.float32) + b.astype(jnp.float32)).astype(x.dtype)


def ada_params(cond, w, b):
    m = (jax.nn.silu(cond) @ w + b)[..., None, :]
    return jnp.split(m, N_MOD, axis=-1)


def modulate(x, shift, scale):
    return x * (1 + scale) + shift


def ffn_half(x, mods, g, w_gu, w_d):
    shift, scale, gate = mods
    h = modulate(rmsnorm(x, g), shift, scale) @ w_gu
    hg, hu = jnp.split(h, 2, axis=-1)
    return x + 0.5 * gate * ((jax.nn.silu(hg) * hu) @ w_d)


def axial_rope_tables(n):
    rows = n // GRID_W
    row = jnp.repeat(jnp.arange(rows, dtype=jnp.float32), GRID_W)
    col = jnp.tile(jnp.arange(GRID_W, dtype=jnp.float32), rows)
    inv = ROPE_BASE ** (-jnp.arange(ROPE_FREQS, dtype=jnp.float32) / ROPE_FREQS)
    ang = jnp.concatenate([row[:, None] * inv, col[:, None] * inv], axis=-1)
    return jnp.cos(ang), jnp.sin(ang)


def apply_rope(x, cos, sin):
    n = x.shape[1]
    xr = x.astype(jnp.float32).reshape(x.shape[:-1] + (2, 2, ROPE_FREQS))
    x1, x2 = xr[..., 0, :], xr[..., 1, :]
    c = cos.reshape(n, 1, 2, ROPE_FREQS)
    s = sin.reshape(n, 1, 2, ROPE_FREQS)
    out = jnp.stack([x1 * c - x2 * s, x2 * c + x1 * s], axis=-2)
    return out.reshape(x.shape).astype(x.dtype)


def conv_module(val, gate, w_dw, b_dw, ln_g, ln_b):
    u = val * jax.nn.sigmoid(gate)
    u = lax.conv_general_dilated(u, w_dw[:, None, :], window_strides=(1,), padding=[(CONV_PAD, CONV_PAD)],
                                 dimension_numbers=("NWC", "WIO", "NWC"), feature_group_count=CONV_DIM) + b_dw
    return jax.nn.silu(layernorm(u, ln_g, ln_b))


def banded(t, nb):
    tb = t.reshape(t.shape[0], nb, BLOCK, ATT_KV_HEADS, HEAD_DIM)
    tp = jnp.pad(tb, ((0, 0), (1, 1), (0, 0), (0, 0), (0, 0)))
    return jnp.concatenate([tp[:, :-2], tp[:, 1:-1], tp[:, 2:]], axis=2)


def band_mask(nb):
    r = jnp.arange(BLOCK)[:, None]
    j = jnp.arange(3 * BLOCK)[None, :]
    rel = j - BLOCK - r
    kpos = (jnp.arange(nb)[:, None, None] - 1) * BLOCK + j[None]
    return (jnp.abs(rel) <= WINDOW)[None] & (kpos >= 0) & (kpos < nb * BLOCK)


def sink_logits(sink, shape):
    s = sink.astype(jnp.float32).reshape((1, ATT_KV_HEADS, ATT_GROUP) + (1,) * (len(shape) - 3))
    return jnp.broadcast_to(s, shape[:-1] + (1,))


def window_attn_latent(q, k, v, kc, vc, sink):
    B, S = q.shape[:2]
    nb = S // BLOCK
    nk = 3 * BLOCK
    ncx = kc.shape[1]
    scale = HEAD_DIM ** -0.5
    qb = q.reshape(B, nb, BLOCK, ATT_KV_HEADS, ATT_GROUP, HEAD_DIM)
    kb, vb = banded(k, nb), banded(v, nb)
    s_band = jnp.einsum("bnqkgd,bnjkd->bkgnqj", qb, kb).astype(jnp.float32) * scale
    s_band = jnp.where(band_mask(nb), s_band, -jnp.inf)
    s_ctx = jnp.einsum("bnqkgd,bckd->bkgnqc", qb, kc).astype(jnp.float32) * scale
    p = jax.nn.softmax(jnp.concatenate([s_band, s_ctx, sink_logits(sink, s_band.shape)], axis=-1), axis=-1)
    o = (jnp.einsum("bkgnqj,bnjkd->bnqkgd", p[..., :nk].astype(v.dtype), vb)
         + jnp.einsum("bkgnqc,bckd->bnqkgd", p[..., nk:nk + ncx].astype(v.dtype), vc))
    return o.reshape(B, S, ATT_DIM)


def attn_context(qc, kc, vc, sink):
    B, C = qc.shape[:2]
    qg = qc.reshape(B, C, ATT_KV_HEADS, ATT_GROUP, HEAD_DIM)
    s = jnp.einsum("bqkgd,bckd->bkgqc", qg, kc).astype(jnp.float32) * HEAD_DIM ** -0.5
    p = jax.nn.softmax(jnp.concatenate([s, sink_logits(sink, s.shape)], axis=-1), axis=-1)
    o = jnp.einsum("bkgqc,bckd->bqkgd", p[..., :C].astype(vc.dtype), vc)
    return o.reshape(B, C, ATT_DIM)


def even_mixer(hl, hc, w_in, conv_w, conv_b, ln_g, ln_b, sink, w_out, cos, sin, with_ctx_out):
    B, S, _ = hl.shape
    C = hc.shape[1]
    pl = hl @ w_in
    a_l = conv_module(pl[..., :CONV_DIM], pl[..., CONV_DIM:Q_OFF], conv_w, conv_b, ln_g, ln_b)
    q = apply_rope(pl[..., Q_OFF:K_OFF].reshape(B, S, ATT_HEADS, HEAD_DIM), cos, sin)
    k = apply_rope(pl[..., K_OFF:V_OFF].reshape(B, S, ATT_KV_HEADS, HEAD_DIM), cos, sin)
    v = pl[..., V_OFF:].reshape(B, S, ATT_KV_HEADS, HEAD_DIM)
    pkv = hc @ w_in[:, K_OFF:]
    kc = pkv[..., :KV_DIM].reshape(B, C, ATT_KV_HEADS, HEAD_DIM)
    vc = pkv[..., KV_DIM:].reshape(B, C, ATT_KV_HEADS, HEAD_DIM)
    att_l = window_attn_latent(q, k, v, kc, vc, sink)
    yl = jnp.concatenate([a_l, att_l], axis=-1) @ w_out
    if not with_ctx_out:
        return yl, None
    pc = hc @ w_in[:, :K_OFF]
    a_c = conv_module(pc[..., :CONV_DIM], pc[..., CONV_DIM:Q_OFF], conv_w, conv_b, ln_g, ln_b)
    att_c = attn_context(pc[..., Q_OFF:].reshape(B, C, ATT_HEADS, HEAD_DIM), kc, vc, sink)
    yc = jnp.concatenate([a_c, att_c], axis=-1) @ w_out
    return yl, yc


def mlstm_zero_state(B):
    f32 = jnp.float32
    return (jnp.zeros((B, ML_HEADS, ML_HEAD_DIM, ML_HEAD_DIM), f32),
            jnp.zeros((B, ML_HEADS, ML_HEAD_DIM), f32),
            jnp.zeros((B, ML_HEADS), f32))


def mlstm_scan(q, k, v, i_pre, f_pre, state, with_out):
    B, n, H, dh = q.shape
    nc = n // ML_CHUNK
    f32 = jnp.float32

    def chunks(t):
        return jnp.moveaxis(t.astype(f32).reshape((B, nc, ML_CHUNK) + t.shape[2:]), 1, 0)

    xs = (chunks(q), chunks(k * dh ** -0.5), chunks(v), chunks(i_pre),
          chunks(jax.nn.log_sigmoid(f_pre.astype(f32))))
    causal = jnp.tril(jnp.ones((ML_CHUNK, ML_CHUNK), bool))[None, :, :, None]

    def step(carry, inp):
        Cm, nv, m = carry
        qc, kc, vc, li, lf = inp
        b = jnp.cumsum(lf, axis=1)
        b_end = b[:, -1]
        w_end = b_end[:, None] - b + li
        m_new = jnp.maximum(b_end + m, jnp.max(w_end, axis=1))
        decay = jnp.exp(b_end + m - m_new)
        wk = jnp.exp(w_end - m_new[:, None])[..., None] * kc
        C_new = decay[..., None, None] * Cm + jnp.einsum("blhv,blhk->bhvk", vc, wk)
        n_new = decay[..., None] * nv + jnp.sum(wk, axis=1)
        if not with_out:
            return (C_new, n_new, m_new), None
        dmat = jnp.where(causal, b[:, :, None] - b[:, None] + li[:, None], -jnp.inf)
        inter = b + m[:, None]
        m_q = jnp.maximum(jnp.max(dmat, axis=2), inter)
        s = jnp.einsum("bqhd,bkhd->bqkh", qc, kc) * jnp.exp(dmat - m_q[:, :, None])
        w_inter = jnp.exp(inter - m_q)
        num = (jnp.einsum("bqkh,bkhd->bqhd", s, vc)
               + w_inter[..., None] * jnp.einsum("bhvk,bqhk->bqhv", Cm, qc))
        den = jnp.sum(s, axis=2) + w_inter * jnp.einsum("bhk,bqhk->bqh", nv, qc)
        h = num / jnp.maximum(jnp.abs(den), jnp.exp(-m_q))[..., None]
        return (C_new, n_new, m_new), h

    state, hs = lax.scan(step, state, xs)
    if with_out:
        hs = jnp.moveaxis(hs, 0, 1).reshape(B, n, H, dh)
    return state, hs


def odd_mixer(hl, hc, w_in, b_gate, norm_g, w_out, with_ctx_out):
    def qkv_gates(h):
        B, n, _ = h.shape
        qkv = (h @ w_in[:, :3 * ML_DIM]).reshape(B, n, 3, ML_HEADS, ML_HEAD_DIM)
        g = (h @ w_in[:, 4 * ML_DIM:] + b_gate).astype(jnp.float32).reshape(B, n, 4, ML_HEADS)
        return qkv[:, :, 0], qkv[:, :, 1], qkv[:, :, 2], g

    def out(h, h_sum):
        B, n, _ = h.shape
        o = jax.nn.sigmoid(h @ w_in[:, 3 * ML_DIM:4 * ML_DIM])
        hn = h_sum * lax.rsqrt(jnp.mean(h_sum * h_sum, axis=-1, keepdims=True) + EPS)
        hn = hn.reshape(B, n, ML_DIM) * norm_g.astype(jnp.float32)
        return (o * hn.astype(h.dtype)) @ w_out

    flip = lambda t: jnp.flip(t, axis=1)
    ql, kl, vl, gl = qkv_gates(hl)
    qc, kc, vc, gc = qkv_gates(hc)
    z = mlstm_zero_state(hl.shape[0])
    st_f, hcf = mlstm_scan(qc, kc, vc, gc[:, :, 0], gc[:, :, 1], z, with_ctx_out)
    st_b, hcb = mlstm_scan(flip(qc), flip(kc), flip(vc), flip(gc[:, :, 2]), flip(gc[:, :, 3]), z, with_ctx_out)
    _, hlf = mlstm_scan(ql, kl, vl, gl[:, :, 0], gl[:, :, 1], st_f, True)
    _, hlb = mlstm_scan(flip(ql), flip(kl), flip(vl), flip(gl[:, :, 2]), flip(gl[:, :, 3]), st_b, True)
    yl = out(hl, hlf + flip(hlb))
    if not with_ctx_out:
        return yl, None
    return yl, out(hc, hcf + flip(hcb))


def setup_inputs(seed: int = 0) -> dict:
    key = jax.random.key(seed)
    ks = iter(jax.random.split(key, 32))
    f32 = jnp.float32
    D = D_MODEL

    def nrm(shape, s):
        return jax.random.normal(next(ks), shape, f32) * s

    def gain(shape):
        return 1.0 + nrm(shape, 0.02)

    gate_offset = jnp.tile(jnp.repeat(jnp.array([0.0, FORGET_BIAS], f32), ML_HEADS), 2)
    return {
        "x": nrm((BATCH, SEQ, D), 1.0),
        "c": nrm((BATCH, D), 1.0),
        "ctx": nrm((BATCH, CTX_LEN, D), 1.0),
        "c_ctx": nrm((D,), 1.0),
        "mod_w": nrm((DEPTH, D, N_MOD * D), 0.5 * D ** -0.5),
        "mod_b": nrm((DEPTH, N_MOD * D), 0.02),
        "ffn1_norm": gain((DEPTH, D)),
        "ffn1_w_gu": nrm((DEPTH, D, 2 * D_FF), D ** -0.5),
        "ffn1_w_d": nrm((DEPTH, D_FF, D), D_FF ** -0.5),
        "mix_norm": gain((DEPTH, D)),
        "ffn2_norm": gain((DEPTH, D)),
        "ffn2_w_gu": nrm((DEPTH, D, 2 * D_FF), D ** -0.5),
        "ffn2_w_d": nrm((DEPTH, D_FF, D), D_FF ** -0.5),
        "ev_w_in": nrm((N_EVEN, D, EVEN_IN), D ** -0.5),
        "ev_conv_w": nrm((N_EVEN, CONV_WIDTH, CONV_DIM), CONV_WIDTH ** -0.5),
        "ev_conv_b": nrm((N_EVEN, CONV_DIM), 0.02),
        "ev_conv_ln_g": gain((N_EVEN, CONV_DIM)),
        "ev_conv_ln_b": nrm((N_EVEN, CONV_DIM), 0.02),
        "ev_sink": nrm((N_EVEN, ATT_HEADS), 0.5),
        "ev_w_out": nrm((N_EVEN, EVEN_MIX, D), EVEN_MIX ** -0.5),
        "od_w_in": nrm((N_ODD, D, ODD_IN), D ** -0.5),
        "od_b_gate": gate_offset[None] + nrm((N_ODD, 4 * ML_HEADS), 0.3),
        "od_norm_g": gain((N_ODD, ML_DIM)),
        "od_w_out": nrm((N_ODD, ML_DIM, D), ML_DIM ** -0.5),
        "final_norm": gain((D,)),
    }


def reference(x, c, ctx, c_ctx, mod_w, mod_b, ffn1_norm, ffn1_w_gu, ffn1_w_d, mix_norm,
              ffn2_norm, ffn2_w_gu, ffn2_w_d, ev_w_in, ev_conv_w, ev_conv_b, ev_conv_ln_g,
              ev_conv_ln_b, ev_sink, ev_w_out, od_w_in, od_b_gate, od_norm_g, od_w_out, final_norm):
    cos, sin = axial_rope_tables(x.shape[1])
    xl, xc = x, ctx
    for l in range(DEPTH):
        last = l == DEPTH - 1
        ml = ada_params(c, mod_w[l], mod_b[l])
        mc = ada_params(c_ctx, mod_w[l], mod_b[l])
        xl = ffn_half(xl, ml[0:3], ffn1_norm[l], ffn1_w_gu[l], ffn1_w_d[l])
        xc = ffn_half(xc, mc[0:3], ffn1_norm[l], ffn1_w_gu[l], ffn1_w_d[l])
        hl = modulate(rmsnorm(xl, mix_norm[l]), ml[3], ml[4])
        hc = modulate(rmsnorm(xc, mix_norm[l]), mc[3], mc[4])
        j = l // 2
        if l % 2 == 0:
            yl, yc = even_mixer(hl, hc, ev_w_in[j], ev_conv_w[j], ev_conv_b[j], ev_conv_ln_g[j],
                                ev_conv_ln_b[j], ev_sink[j], ev_w_out[j], cos, sin, not last)
        else:
            yl, yc = odd_mixer(hl, hc, od_w_in[j], od_b_gate[j], od_norm_g[j], od_w_out[j], not last)
        xl = xl + ml[5] * yl
        xl = ffn_half(xl, ml[6:9], ffn2_norm[l], ffn2_w_gu[l], ffn2_w_d[l])
        if not last:
            xc = xc + mc[5] * yc
            xc = ffn_half(xc, mc[6:9], ffn2_norm[l], ffn2_w_gu[l], ffn2_w_d[l])
    return rmsnorm(xl, final_norm)
```

```cpp
#include <hip/hip_runtime.h>
#include <hip/hip_cooperative_groups.h>
#include <cstdio>
#include <cstdint>
namespace cg = cooperative_groups;
typedef unsigned short bf16_t;
typedef short bf16x8 __attribute__((ext_vector_type(8)));
typedef short s16x4 __attribute__((ext_vector_type(4)));
typedef float f32x4 __attribute__((ext_vector_type(4)));
typedef float f32x2 __attribute__((ext_vector_type(2)));
typedef unsigned u32x4 __attribute__((ext_vector_type(4)));
typedef unsigned u32x2 __attribute__((ext_vector_type(2)));
typedef __bf16 bf16x2_t __attribute__((ext_vector_type(2)));
__device__ __forceinline__ unsigned pk2(float lo, float hi) { f32x2 v = {lo, hi}; bf16x2_t b = __builtin_convertvector(v, bf16x2_t); return __builtin_bit_cast(unsigned, b); }
__device__ __forceinline__ float bflo(unsigned u) { return __uint_as_float(u << 16); }
__device__ __forceinline__ float bfhi(unsigned u) { return __uint_as_float(u & 0xffff0000u); }
__device__ __forceinline__ float bf2f(bf16_t u) { return __uint_as_float(((unsigned)u) << 16); }
__device__ __forceinline__ float wave_sum(float v) {
#pragma unroll
    for (int o = 1; o < 64; o <<= 1) v += __shfl_xor(v, o);
    return v;
}
__device__ __forceinline__ float sigmoidf_(float x) { return __builtin_amdgcn_rcpf(1.f + __expf(-x)); }
__device__ __forceinline__ float siluf_(float x) { return x * sigmoidf_(x); }

__device__ __forceinline__ int tid_opaque() { int t = threadIdx.x; asm volatile("" : "+v"(t)); return t; }
constexpr int D = 1024, NB = 4, SEQ = 4096, CTXL = 256, ML = NB * SEQ, MC = NB * CTXL, M = ML + MC, FF = 2816, NMODC = 9 * D;
constexpr int EVIN = 1792, ODIN = 4112, ODN = 4096;
constexpr float EPS = 1e-6f;
constexpr float QSCALE = 0.125f * 1.4426950408889634f;
constexpr float LOG2E = 1.4426950408889634f;
constexpr size_t MiB = 1u << 20;
constexpr size_t WS_MODS = 0;
constexpr size_t WS_SB = 512 * 1024;
constexpr size_t WS_RS = 1536 * 1024;
constexpr size_t WS_GATES = 2 * MiB;
constexpr size_t WS_ROPE = 2 * MiB + 1536 * 1024;
constexpr size_t WS_BAR = 3 * MiB + 768 * 1024;
constexpr size_t WS_QCTR = 3 * MiB + 896 * 1024;
constexpr size_t WS_XC = 4 * MiB;
constexpr size_t WS_WGU = 8 * MiB;
constexpr size_t WS_WD = WS_WGU + 44 * MiB;
constexpr size_t WS_WEIN = WS_WD + 22 * MiB;
constexpr size_t WS_WEOUT = WS_WEIN + 3 * MiB + 512 * 1024;
constexpr size_t WS_WOIN = WS_WEOUT + 2 * MiB;
constexpr size_t WS_WOOUT = WS_WOIN + 8 * MiB;
constexpr size_t WS_XN = 90 * MiB;
constexpr size_t WS_BIG = 124 * MiB;
static_assert(WS_WOOUT + 2 * MiB <= WS_XN, "weights fit");
constexpr size_t WS_ACT = WS_BIG;
constexpr size_t WS_U = WS_BIG;
constexpr size_t WS_Q = WS_BIG + 17 * MiB;
constexpr size_t WS_KV = WS_BIG + 34 * MiB;
constexpr size_t WS_MIXA_E = WS_BIG + 43 * MiB;
constexpr size_t WS_QKV = WS_BIG;
constexpr size_t WS_HF = WS_BIG + 102 * MiB;
constexpr size_t WS_HB = WS_BIG + 134 * MiB;
constexpr size_t WS_HN = WS_QKV;
constexpr size_t WS_MIXA_O = WS_QKV + 34 * MiB;
constexpr size_t WS_PART = WS_BIG + 94 * MiB;
constexpr size_t WS_END = WS_BIG + 166 * MiB;
constexpr size_t WS_SCG = WS_END;
constexpr size_t WS_END2 = WS_SCG + (size_t)256 * 34 * 384 * 4;
constexpr int LDS_BYTES = 147456;
namespace pg8 {
#define PG8_LAS __attribute__((address_space(3)))
typedef unsigned short bf16_t;
typedef short bf16x8 __attribute__((ext_vector_type(8)));
typedef float f32x4 __attribute__((ext_vector_type(4)));
typedef unsigned u32x4 __attribute__((ext_vector_type(4)));
constexpr int BM = 256, BK = 64, HALF = 128, HTB = HALF * BK * 2  , STAGE_BYTES = 8 * HTB, NXCD = 8, WGM = 8;

__host__ __device__ __forceinline__ int lds_byte(int r, int c) { const int st = (r >> 4) * 2 + (c >> 5), rr = r & 15, cc = c & 31, ob = rr * 64 + cc * 2; return st * 1024 + (ob ^ (((ob >> 9) & 1) << 5)); }
__host__ __device__ __forceinline__ void stage_rc(int b, int& R, int& C) { const int st = b / 1024, sb = b % 1024, swz = sb ^ (((sb >> 9) & 1) << 5); R = (st >> 1) * 16 + swz / 64; C = (st & 1) * 32 + (swz % 64) / 2; }
__host__ __device__ __forceinline__ int perm32(int rho) { const int n = rho >> 4, i = rho & 15; return 8 * (i >> 2) + 4 * n + (i & 3); }

struct Unit { int pm, pn, k0t, ntu; };
struct Gemm { const bf16_t* A; const bf16_t* Bt; int M, N, K; };

struct StaticOrder {
    int nM, nN, nwg, G, c;
    __host__ __device__ void init(int M, int N, int G_, int c_) { nM = M / BM; nN = N / BM; nwg = nM * nN; G = G_; c = c_; }
    __host__ __device__ bool next(int i, Unit& u) const {
        const long L = (long)i * G + c; if (L >= nwg) return false;
        int wgid = (int)L; { const int q = nwg / NXCD, r = nwg % NXCD, xcd = wgid % NXCD, off = wgid / NXCD; wgid = (xcd < r ? xcd * (q + 1) : r * (q + 1) + (xcd - r) * q) + off; }
        const int nig = WGM * nN, gid = wgid / nig, fm = gid * WGM, gsz = (nM - fm) < WGM ? (nM - fm) : WGM;
        u.pm = fm + ((wgid % nig) % gsz); u.pn = (wgid % nig) / gsz; return true;
    }
    __device__ __forceinline__ void a_ready(const Unit&) const {}
    __device__ __forceinline__ void done(const Unit&) const {}
};

struct Order {
    int nM, nN, nwg, G, c, ntf, nx, xpm0, xpn0, xnn, nsl;
    __device__ void init(int Mr, int N, int K, int G_, int c_, int nx_ = 0, int xpm0_ = 0, int xpn0_ = 0, int xnn_ = 1, int nsl_ = 1) { nM = Mr / BM; nN = N / BM; nwg = nM * nN; G = G_; c = c_; ntf = K / BK; nx = nx_; xpm0 = xpm0_; xpn0 = xpn0_; xnn = xnn_; nsl = nsl_; }
    __device__ bool next(int i, Unit& u) const {
        const long L = (long)i * G + c; if (L >= nwg + nx) return false;
        u.k0t = 0; u.ntu = ntf;
        if (L >= nwg) { const int e = (int)L - nwg, cu = e / nsl, sl = e % nsl; u.pm = xpm0 + cu / xnn; u.pn = xpn0 + cu % xnn; u.ntu = ntf / nsl; u.k0t = sl * u.ntu; return true; }
        int wgid = (int)L; { const int q = nwg / NXCD, r = nwg % NXCD, xcd = wgid % NXCD, off = wgid / NXCD; wgid = (xcd < r ? xcd * (q + 1) : r * (q + 1) + (xcd - r) * q) + off; }
        const int nig = WGM * nN, gid = wgid / nig, fm = gid * WGM, gsz = (nM - fm) < WGM ? (nM - fm) : WGM;
        u.pm = fm + ((wgid % nig) % gsz); u.pn = (wgid % nig) / gsz; return true;
    }
    __device__ __forceinline__ void a_ready(const Unit&) const {}
    __device__ __forceinline__ void done(const Unit&) const {}
};
__device__ __forceinline__ float rstd_of(float ssq) { return __builtin_amdgcn_rsqf(ssq * (1.0f / 1024.0f) + ::EPS); }
__device__ __forceinline__ int cond_of(int pm) { return pm < 64 ? (pm >> 4) : 4; }

struct EpiFFNUp {
    static constexpr bool PERM = true, AFTER_DRAIN = false;
    const float* rs; const float* sb; bf16_t* act;
    __device__ __forceinline__ void operator()(const f32x4 (&acc)[2][2][4][2], const Unit& u, int wr, int wc, int fr, int fq) const {
        const int ci = cond_of(u.pm);
        const float* sbp = sb + ci * 5632 + u.pn * 256 + wc * 32 + 8 * fq;
        const f32x4 bg0 = *(const f32x4*)(sbp), bg1 = *(const f32x4*)(sbp + 4), bu0 = *(const f32x4*)(sbp + 128), bu1 = *(const f32x4*)(sbp + 132);
        const int ocol = u.pn * 128 + wc * 32 + 8 * fq;
#pragma unroll
        for (int ai = 0; ai < 2; ++ai)
#pragma unroll
            for (int m = 0; m < 4; ++m) {
                const int row = u.pm * BM + ai * HALF + wr * 64 + m * 16 + fr;
                const float r = rstd_of(rs[row]);
                const f32x4 g0 = acc[ai][0][m][0] * r + bg0, g1 = acc[ai][0][m][1] * r + bg1, u0 = acc[ai][1][m][0] * r + bu0, u1 = acc[ai][1][m][1] * r + bu1;
                u32x4 w;
                w.x = ::pk2(::siluf_(g0[0]) * u0[0], ::siluf_(g0[1]) * u0[1]); w.y = ::pk2(::siluf_(g0[2]) * u0[2], ::siluf_(g0[3]) * u0[3]);
                w.z = ::pk2(::siluf_(g1[0]) * u1[0], ::siluf_(g1[1]) * u1[1]); w.w = ::pk2(::siluf_(g1[2]) * u1[2], ::siluf_(g1[3]) * u1[3]);
                *(u32x4*)(act + (size_t)row * ::FF + ocol) = w;
            }
    }
};
template <int GC2> struct EpiResid {
    static constexpr bool PERM = true, AFTER_DRAIN = false;
    const float* base_l; const float* base_c; float* out_l; float* out_c;
    const float* gate;
    const float* ng; const float* nscale;
    bf16_t* xn; float* rs_next;
    float* part;
    __device__ __forceinline__ void operator()(const f32x4 (&acc)[2][2][4][2], const Unit& u, int wr, int wc, int fr, int fq) const {
        const int ci = cond_of(u.pm); constexpr float gcoef = 0.5f * GC2;
        const bool lat = u.pm < 64;
        const bool slice = !lat && part != nullptr;
        const float* bp = lat ? base_l : base_c; float* op = slice ? part + (size_t)(u.k0t / u.ntu) * ::MC * ::D : (lat ? out_l : out_c);
        const float* ngu = slice ? nullptr : ng; float* rsu = slice ? nullptr : rs_next;
        const int rbase = lat ? u.pm * BM : (u.pm - 64) * BM;
        const int col0 = u.pn * BM + wc * 32 + 8 * fq;
        float ss[2][4];
#pragma unroll
        for (int ai = 0; ai < 2; ++ai)
#pragma unroll
            for (int m = 0; m < 4; ++m) ss[ai][m] = 0.f;
#pragma unroll
        for (int bj = 0; bj < 2; ++bj) {
            const int col = col0 + bj * HALF;
            f32x4 g0 = (f32x4){1.f, 1.f, 1.f, 1.f}, g1 = g0;
            if (!slice) { g0 = *(const f32x4*)(gate + ci * ::NMODC + col) * gcoef; g1 = *(const f32x4*)(gate + ci * ::NMODC + col + 4) * gcoef; }
            f32x4 s0 = (f32x4){0.f, 0.f, 0.f, 0.f}, s1 = s0;
            if (ngu) { s0 = *(const f32x4*)(ng + col) * (*(const f32x4*)(nscale + ci * ::NMODC + col) + 1.0f); s1 = *(const f32x4*)(ng + col + 4) * (*(const f32x4*)(nscale + ci * ::NMODC + col + 4) + 1.0f); }
#pragma unroll
            for (int ai = 0; ai < 2; ++ai)
#pragma unroll
                for (int m = 0; m < 4; ++m) {
                    const int rl = rbase + ai * HALF + wr * 64 + m * 16 + fr;
                    const int rg = u.pm * BM + ai * HALF + wr * 64 + m * 16 + fr;
                    const size_t off = (size_t)rl * ::D + col;
                    f32x4 b0 = (f32x4){0.f, 0.f, 0.f, 0.f}, b1 = b0;
                    if (!slice) { b0 = *(const f32x4*)(bp + off); b1 = *(const f32x4*)(bp + off + 4); }
                    const f32x4 x0 = b0 + g0 * acc[ai][bj][m][0], x1 = b1 + g1 * acc[ai][bj][m][1];
                    *(f32x4*)(op + off) = x0; *(f32x4*)(op + off + 4) = x1;
                    ss[ai][m] += (x0[0] * x0[0] + x0[1] * x0[1]) + (x0[2] * x0[2] + x0[3] * x0[3]) + (x1[0] * x1[0] + x1[1] * x1[1]) + (x1[2] * x1[2] + x1[3] * x1[3]);
                    if (ngu) { const f32x4 y0 = x0 * s0, y1 = x1 * s1; u32x4 w; w.x = ::pk2(y0[0], y0[1]); w.y = ::pk2(y0[2], y0[3]); w.z = ::pk2(y1[0], y1[1]); w.w = ::pk2(y1[2], y1[3]);
                        *(u32x4*)(xn + (size_t)rg * ::D + col) = w; }
                }
        }
        if (rsu) {
#pragma unroll
            for (int ai = 0; ai < 2; ++ai)
#pragma unroll
                for (int m = 0; m < 4; ++m) { float t = ss[ai][m]; t += __shfl_xor(t, 16); t += __shfl_xor(t, 32); if (fq == 0) atomicAdd(rsu + u.pm * BM + ai * HALF + wr * 64 + m * 16 + fr, t); }
        }
    }
};
struct EpiEvenIn {
    static constexpr bool PERM = false, AFTER_DRAIN = false;
    const float* rs; const float* sb; const float* rcos; const float* rsin; bf16_t* U; bf16_t* Q; bf16_t* KV;
    __device__ __forceinline__ void operator()(const f32x4 (&acc)[2][2][4][2], const Unit& u, int wr, int wc, int fr, int fq) const {
        const int ci = cond_of(u.pm); const bool lat = u.pm < 64;
        const float* sbp = sb + ci * 5632 + u.pn * 256 + wc * 32 + 4 * fq;
        f32x4 bv[2][2];
#pragma unroll
        for (int bj = 0; bj < 2; ++bj)
#pragma unroll
            for (int n = 0; n < 2; ++n) bv[bj][n] = *(const f32x4*)(sbp + bj * HALF + 16 * n);
        const int cw = wc * 32 + 4 * fq;
#pragma unroll
        for (int ai = 0; ai < 2; ++ai)
#pragma unroll
            for (int m = 0; m < 4; ++m) {
                const int row = u.pm * BM + ai * HALF + wr * 64 + m * 16 + fr;
                const float r = rstd_of(rs[row]);
                f32x4 h[2][2];
#pragma unroll
                for (int bj = 0; bj < 2; ++bj)
#pragma unroll
                    for (int n = 0; n < 2; ++n) h[bj][n] = acc[ai][bj][m][n] * r + bv[bj][n];
                if (u.pn < 4) {
#pragma unroll
                    for (int n = 0; n < 2; ++n) { const f32x4 v = h[0][n], g = h[1][n]; u32x2 w; w.x = ::pk2(v[0] * ::sigmoidf_(g[0]), v[1] * ::sigmoidf_(g[1])); w.y = ::pk2(v[2] * ::sigmoidf_(g[2]), v[3] * ::sigmoidf_(g[3]));
                        *(u32x2*)(U + (size_t)row * 512 + u.pn * 128 + cw + 16 * n) = w; }
                } else {
                    f32x4 cs = (f32x4){1.f, 1.f, 1.f, 1.f}, sn = (f32x4){0.f, 0.f, 0.f, 0.f};
                    if (lat) { const int pos = row & (::SEQ - 1); const int p = (wc & 1) ? (pos & 63) : (pos >> 6); cs = *(const f32x4*)(rcos + p * 16 + 4 * fq); sn = *(const f32x4*)(rsin + p * 16 + 4 * fq); }
                    if (u.pn < 6) {
#pragma unroll
                        for (int bj = 0; bj < 2; ++bj) { const f32x4 x1 = h[bj][0], x2 = h[bj][1]; const f32x4 o1 = (x1 * cs - x2 * sn) * ::QSCALE, o2 = (x2 * cs + x1 * sn) * ::QSCALE;
                            bf16_t* qp = Q + (size_t)row * 512 + (u.pn - 4) * 256 + bj * HALF + cw;
                            u32x2 w; w.x = ::pk2(o1[0], o1[1]); w.y = ::pk2(o1[2], o1[3]); *(u32x2*)(qp) = w; w.x = ::pk2(o2[0], o2[1]); w.y = ::pk2(o2[2], o2[3]); *(u32x2*)(qp + 16) = w; }
                    } else {
                        { const f32x4 x1 = h[0][0], x2 = h[0][1]; const f32x4 o1 = x1 * cs - x2 * sn, o2 = x2 * cs + x1 * sn; bf16_t* kp = KV + (size_t)row * 256 + cw;
                            u32x2 w; w.x = ::pk2(o1[0], o1[1]); w.y = ::pk2(o1[2], o1[3]); *(u32x2*)(kp) = w; w.x = ::pk2(o2[0], o2[1]); w.y = ::pk2(o2[2], o2[3]); *(u32x2*)(kp + 16) = w; }
                        { bf16_t* vp = KV + (size_t)row * 256 + 128 + cw;
#pragma unroll
                            for (int n = 0; n < 2; ++n) { const f32x4 v = h[1][n]; u32x2 w; w.x = ::pk2(v[0], v[1]); w.y = ::pk2(v[2], v[3]); *(u32x2*)(vp + 16 * n) = w; } }
                    }
                }
            }
    }
};
struct EpiOddIn {
    static constexpr bool PERM = true, AFTER_DRAIN = false;
    const float* rs; const float* sb; bf16_t* QKV;
    __device__ __forceinline__ void operator()(const f32x4 (&acc)[2][2][4][2], const Unit& u, int wr, int wc, int fr, int fq) const {
        const int ci = cond_of(u.pm);
        const float* sbp = sb + ci * 5632 + u.pn * 256 + wc * 32 + 8 * fq;
        const int which = u.pn >> 2; const float sc = which == 1 ? 0.0625f : 1.0f;
        bf16_t* dst = QKV + (size_t)which * ::M * ::D + (u.pn & 3) * 256 + wc * 32 + 8 * fq;
        f32x4 bv[2][2];
#pragma unroll
        for (int bj = 0; bj < 2; ++bj)
#pragma unroll
            for (int n = 0; n < 2; ++n) bv[bj][n] = *(const f32x4*)(sbp + bj * HALF + 4 * n);
#pragma unroll
        for (int ai = 0; ai < 2; ++ai)
#pragma unroll
            for (int m = 0; m < 4; ++m) {
                const int row = u.pm * BM + ai * HALF + wr * 64 + m * 16 + fr;
                const float r = rstd_of(rs[row]);
#pragma unroll
                for (int bj = 0; bj < 2; ++bj) { const f32x4 v0 = (acc[ai][bj][m][0] * r + bv[bj][0]) * sc, v1 = (acc[ai][bj][m][1] * r + bv[bj][1]) * sc;
                    u32x4 w; w.x = ::pk2(v0[0], v0[1]); w.y = ::pk2(v0[2], v0[3]); w.z = ::pk2(v1[0], v1[1]); w.w = ::pk2(v1[2], v1[3]);
                    *(u32x4*)(dst + (size_t)row * ::D + bj * HALF) = w; }
            }
    }
};
struct EpiOddGate {
    static constexpr bool PERM = true, AFTER_DRAIN = false;
    const float* rs; const float* sb; const bf16_t* HN; bf16_t* MIXA;
    __device__ __forceinline__ void operator()(const f32x4 (&acc)[2][2][4][2], const Unit& u, int wr, int wc, int fr, int fq) const {
        const int ci = cond_of(u.pm);
        const int col0 = u.pn * 256 + wc * 32 + 8 * fq;
        const float* sbp = sb + ci * 5632 + 3072 + col0;
        f32x4 bv[2][2];
#pragma unroll
        for (int bj = 0; bj < 2; ++bj)
#pragma unroll
            for (int n = 0; n < 2; ++n) bv[bj][n] = *(const f32x4*)(sbp + bj * HALF + 4 * n);
#pragma unroll
        for (int ai = 0; ai < 2; ++ai)
#pragma unroll
            for (int m = 0; m < 4; ++m) {
                const int row = u.pm * BM + ai * HALF + wr * 64 + m * 16 + fr;
                const float r = rstd_of(rs[row]);
#pragma unroll
                for (int bj = 0; bj < 2; ++bj) { const f32x4 v0 = acc[ai][bj][m][0] * r + bv[bj][0], v1 = acc[ai][bj][m][1] * r + bv[bj][1];
                    const u32x4 hn = *(const u32x4*)(HN + (size_t)row * ::D + col0 + bj * HALF);
                    u32x4 w; w.x = ::pk2(::sigmoidf_(v0[0]) * ::bflo(hn.x), ::sigmoidf_(v0[1]) * ::bfhi(hn.x)); w.y = ::pk2(::sigmoidf_(v0[2]) * ::bflo(hn.y), ::sigmoidf_(v0[3]) * ::bfhi(hn.y));
                    w.z = ::pk2(::sigmoidf_(v1[0]) * ::bflo(hn.z), ::sigmoidf_(v1[1]) * ::bfhi(hn.z)); w.w = ::pk2(::sigmoidf_(v1[2]) * ::bflo(hn.w), ::sigmoidf_(v1[3]) * ::bfhi(hn.w));
                    *(u32x4*)(MIXA + (size_t)row * ::D + col0 + bj * HALF) = w; }
            }
    }
};
template <class Epi, class Sched, bool ALIGN_EPI = false, bool SP2 = false>
__device__ __forceinline__ void gemm_phase(PG8_LAS unsigned char* lds, const Gemm g, const Sched& S, const Epi& E) {
    const int tid = ::tid_opaque(), wid = __builtin_amdgcn_readfirstlane(tid >> 6), lane = tid & 63, wr = wid >> 2, wc = wid & 3, fr = lane & 15, fq = lane >> 4;
    const int K = g.K, nt = K / BK;
    unsigned voffA[2], voffB[2];
#pragma unroll
    for (int i = 0; i < 2; ++i) { int R, C; stage_rc(tid * 16 + i * 8192, R, C); const int Rb = Epi::PERM ? ((R & ~31) + perm32(R & 31)) : R;
        voffA[i] = (unsigned)(R * K + C) * 2u; voffB[i] = (unsigned)(Rb * K + C) * 2u; }
    const size_t kstep = (size_t)(BK * 2);
    const size_t hstep = (size_t)HALF * K * 2;
    const size_t tstep = 2 * hstep;
    const unsigned ldsw = (unsigned)wid * 1024u;
    const int aoff = lds_byte(wr * 64 + fr, fq * 8), boff = lds_byte(wc * 32 + fr, fq * 8);
#define PG8_SA(b, h) (((b) * 2 + (h)) * HTB)
#define PG8_SB(b, h) ((4 + (b) * 2 + (h)) * HTB)
#define PG8_STAGE(bufoff, gbase, voff) do { _Pragma("unroll") for (int _i = 0; _i < 2; ++_i) \
        __builtin_amdgcn_global_load_lds((const unsigned*)((const char*)(gbase) + (voff)[_i]), (PG8_LAS unsigned*)(lds + (bufoff) + ldsw + _i * 8192), 16, 0, 0); } while (0)
#define PG8_LDA(dst, b, h) do { _Pragma("unroll") for (int m = 0; m < 4; ++m) _Pragma("unroll") for (int k = 0; k < 2; ++k) dst[m][k] = *(const PG8_LAS bf16x8*)(lds + PG8_SA(b, h) + aoff + m * 2048 + k * 1024); } while (0)
#define PG8_LDB(dst, b, h) do { _Pragma("unroll") for (int n = 0; n < 2; ++n) _Pragma("unroll") for (int k = 0; k < 2; ++k) dst[n][k] = *(const PG8_LAS bf16x8*)(lds + PG8_SB(b, h) + boff + n * 2048 + k * 1024); } while (0)
#define PG8_MMA(ai, bj, At, Bt) do { __builtin_amdgcn_s_setprio(1); _Pragma("unroll") for (int m = 0; m < 4; ++m) _Pragma("unroll") for (int n = 0; n < 2; ++n) _Pragma("unroll") for (int k = 0; k < 2; ++k) \
        acc[ai][bj][m][n] = __builtin_amdgcn_mfma_f32_16x16x32_bf16(Bt[n][k], At[m][k], acc[ai][bj][m][n], 0, 0, 0); __builtin_amdgcn_s_setprio(0); } while (0)
#define PG8_WAIT_V(n) asm volatile("s_waitcnt vmcnt(" #n ")" ::: "memory")
#define PG8_WAIT_L(n) asm volatile("s_waitcnt lgkmcnt(" #n ")" ::: "memory")
#define PG8_BAR __builtin_amdgcn_s_barrier()
#define PG8_SCHED __builtin_amdgcn_sched_barrier(0)
    Unit cur, nxt; int ui = 0;
    if (!S.next(0, cur)) return;
    int cnt = cur.ntu;
    f32x4 acc[2][2][4][2];
#pragma unroll
    for (int a = 0; a < 2; ++a)
#pragma unroll
        for (int b = 0; b < 2; ++b)
#pragma unroll
            for (int m = 0; m < 4; ++m)
#pragma unroll
                for (int n = 0; n < 2; ++n) acc[a][b][m][n] = (f32x4){0.f, 0.f, 0.f, 0.f};
    bf16x8 At[4][2], B0[2][2], B1[2][2];
    const char* cA = (const char*)g.A + (size_t)cur.pm * tstep + (size_t)cur.k0t * kstep; const char* cB = (const char*)g.Bt + (size_t)cur.pn * tstep + (size_t)cur.k0t * kstep;
    S.a_ready(cur);
    if constexpr (SP2) {
        PG8_STAGE(PG8_SB(0, 0), cB, voffB); PG8_STAGE(PG8_SB(0, 1), cB + hstep, voffB); PG8_STAGE(PG8_SA(0, 0), cA, voffA); PG8_STAGE(PG8_SA(0, 1), cA + hstep, voffA);
        if (wr == 1) PG8_BAR;
        PG8_WAIT_V(2); PG8_BAR;
        PG8_STAGE(PG8_SB(1, 0), cB + kstep, voffB); PG8_STAGE(PG8_SA(1, 0), cA + kstep, voffA); PG8_STAGE(PG8_SB(1, 1), cB + hstep + kstep, voffB);
        PG8_WAIT_V(6); PG8_BAR;
    } else {
        PG8_STAGE(PG8_SB(0, 0), cB, voffB); PG8_STAGE(PG8_SA(0, 0), cA, voffA); PG8_STAGE(PG8_SB(0, 1), cB + hstep, voffB); PG8_STAGE(PG8_SA(0, 1), cA + hstep, voffA);
        if (wr == 1) PG8_BAR;
        PG8_WAIT_V(4); PG8_BAR;
        PG8_STAGE(PG8_SB(1, 0), cB + kstep, voffB); PG8_STAGE(PG8_SA(1, 0), cA + kstep, voffA); PG8_STAGE(PG8_SB(1, 1), cB + hstep + kstep, voffB);
        PG8_WAIT_V(6); PG8_BAR;
    }
    for (;;) {
        const bool has_next = S.next(ui + 1, nxt);
        const char* nA = has_next ? (const char*)g.A + (size_t)nxt.pm * tstep + (size_t)nxt.k0t * kstep : cA; const char* nB = has_next ? (const char*)g.Bt + (size_t)nxt.pn * tstep + (size_t)nxt.k0t * kstep : cB;
        for (int t = 0; t < cnt; t += 2) {
            const bool last = (t == cnt - 2);
            const char* a1 = cA + (size_t)(t + 1) * kstep;
            const char* a2 = last ? nA : cA + (size_t)(t + 2) * kstep; const char* b2 = last ? nB : cB + (size_t)(t + 2) * kstep;
            const char* a3 = a2 + kstep; const char* b3 = b2 + kstep;
            if (last && has_next) S.a_ready(nxt);
            if constexpr (SP2) {
            PG8_LDB(B0, 0, 0); PG8_LDB(B1, 0, 1); PG8_SCHED; PG8_LDA(At, 0, 0); PG8_STAGE(PG8_SA(1, 1), a1 + hstep, voffA);
            PG8_WAIT_V(8); PG8_WAIT_L(0); PG8_BAR; PG8_MMA(0, 0, At, B0); PG8_MMA(0, 1, At, B1); PG8_BAR; PG8_SCHED;
            PG8_LDA(At, 0, 1); PG8_STAGE(PG8_SB(0, 0), b2, voffB); PG8_STAGE(PG8_SB(0, 1), b2 + hstep, voffB); PG8_STAGE(PG8_SA(0, 0), a2, voffA);
            PG8_WAIT_V(8); PG8_WAIT_L(0); PG8_BAR; PG8_MMA(1, 0, At, B0); PG8_MMA(1, 1, At, B1); PG8_BAR; PG8_SCHED;
            PG8_LDB(B0, 1, 0); PG8_LDB(B1, 1, 1); PG8_SCHED; PG8_LDA(At, 1, 0); PG8_STAGE(PG8_SA(0, 1), a2 + hstep, voffA);
            PG8_WAIT_V(8); PG8_WAIT_L(0); PG8_BAR; PG8_MMA(0, 0, At, B0); PG8_MMA(0, 1, At, B1); PG8_BAR; PG8_SCHED;
            PG8_LDA(At, 1, 1); PG8_STAGE(PG8_SB(1, 0), b3, voffB); PG8_STAGE(PG8_SB(1, 1), b3 + hstep, voffB); PG8_STAGE(PG8_SA(1, 0), a3, voffA);
            PG8_WAIT_V(8); PG8_WAIT_L(0); PG8_BAR; PG8_MMA(1, 0, At, B0); PG8_MMA(1, 1, At, B1); PG8_BAR; PG8_SCHED;
            } else {
            PG8_LDB(B0, 0, 0); PG8_SCHED; PG8_LDA(At, 0, 0); PG8_STAGE(PG8_SA(1, 1), a1 + hstep, voffA);
            PG8_WAIT_L(8); PG8_BAR; PG8_WAIT_L(0); PG8_MMA(0, 0, At, B0); PG8_BAR; PG8_SCHED;
            PG8_LDB(B1, 0, 1); PG8_STAGE(PG8_SB(0, 0), b2, voffB);
            PG8_BAR; PG8_WAIT_L(0); PG8_MMA(0, 1, At, B1); PG8_BAR;
            PG8_LDA(At, 0, 1); PG8_STAGE(PG8_SA(0, 0), a2, voffA);
            PG8_BAR; PG8_WAIT_L(0); PG8_MMA(1, 0, At, B0); PG8_BAR; PG8_SCHED;
            PG8_STAGE(PG8_SB(0, 1), b2 + hstep, voffB);
            PG8_WAIT_V(6); PG8_BAR; PG8_MMA(1, 1, At, B1); PG8_BAR;
            PG8_LDB(B0, 1, 0); PG8_SCHED; PG8_LDA(At, 1, 0); PG8_STAGE(PG8_SA(0, 1), a2 + hstep, voffA);
            PG8_WAIT_L(8); PG8_BAR; PG8_WAIT_L(0); PG8_MMA(0, 0, At, B0); PG8_BAR; PG8_SCHED;
            PG8_LDB(B1, 1, 1); PG8_STAGE(PG8_SB(1, 0), b3, voffB);
            PG8_BAR; PG8_WAIT_L(0); PG8_MMA(0, 1, At, B1); PG8_BAR;
            PG8_LDA(At, 1, 1); PG8_STAGE(PG8_SA(1, 0), a3, voffA);
            PG8_BAR; PG8_WAIT_L(0); PG8_MMA(1, 0, At, B0); PG8_BAR; PG8_SCHED;
            PG8_STAGE(PG8_SB(1, 1), b3 + hstep, voffB);
            PG8_WAIT_V(6); PG8_BAR; PG8_MMA(1, 1, At, B1); PG8_BAR;
            }
        }
        if constexpr (ALIGN_EPI) { if (wr == 0) PG8_BAR; }
        if constexpr (!Epi::AFTER_DRAIN) { E(acc, cur, wr, wc, fr, fq); S.done(cur); }
        if (!has_next) break;
#pragma unroll
        for (int a = 0; a < 2; ++a)
#pragma unroll
            for (int b = 0; b < 2; ++b)
#pragma unroll
                for (int m = 0; m < 4; ++m)
#pragma unroll
                    for (int n = 0; n < 2; ++n) acc[a][b][m][n] = (f32x4){0.f, 0.f, 0.f, 0.f};
        cur = nxt; cnt = cur.ntu; cA = nA; cB = nB; ++ui;
        if constexpr (ALIGN_EPI) { if (wr == 1) PG8_BAR; }
    }
    PG8_WAIT_V(0);
    if constexpr (!ALIGN_EPI) { if (wr == 0) PG8_BAR; }
    PG8_BAR;
    if constexpr (Epi::AFTER_DRAIN) { E.fused(acc, cur, wr, wc, fr, fq, lds, wid, lane); S.done(cur); }
#undef PG8_SA
#undef PG8_SB
#undef PG8_STAGE
#undef PG8_LDA
#undef PG8_LDB
#undef PG8_MMA
#undef PG8_WAIT_V
#undef PG8_WAIT_L
#undef PG8_BAR
#undef PG8_SCHED
}
}
struct Ctx {
    unsigned char* tab;
    __device__ __forceinline__ unsigned long long ldp(int i) const { const volatile unsigned* p = (const volatile unsigned*)(tab + 8 * i); unsigned lo = p[0], hi = p[1];
        lo = __builtin_amdgcn_readfirstlane(lo); hi = __builtin_amdgcn_readfirstlane(hi); return ((unsigned long long)hi << 32) | lo; }
    __device__ __forceinline__ const float* in(int i) const { return (const float*)(const __attribute__((address_space(1))) float*)ldp(i); }
    __device__ __forceinline__ float* out() const { return (float*)(__attribute__((address_space(1))) float*)ldp(25); }
    __device__ __forceinline__ unsigned char* ws() const { return (unsigned char*)(__attribute__((address_space(1))) unsigned char*)ldp(26); }
};
__device__ __forceinline__ float* ws_f(const Ctx& C, size_t off) { return (float*)(C.ws() + off); }
__device__ __forceinline__ bf16_t* ws_h(const Ctx& C, size_t off) { return (bf16_t*)(C.ws() + off); }

__device__ __forceinline__ void transpose_item(const float* W, int ldw, int K, bf16_t* WT, int k0, int n0, int drow0, float* scr, int lane) {
    float tv[32];
#pragma unroll
    for (int i = 0; i < 32; ++i) { const int kk = 2 * i + (lane >> 5); tv[i] = W[(size_t)(k0 + kk) * ldw + n0 + (lane & 31)]; }
#pragma unroll
    for (int i = 0; i < 32; ++i) { const int kk = 2 * i + (lane >> 5); scr[kk * 33 + (lane & 31)] = tv[i]; }
    __builtin_amdgcn_wave_barrier();
    const int c = lane & 7;
#pragma unroll
    for (int j = 0; j < 4; ++j) { const int n = (lane >> 3) + 8 * j; const float* s = scr + (8 * c) * 33 + n;
        u32x4 o; o.x = pk2(s[0 * 33], s[1 * 33]); o.y = pk2(s[2 * 33], s[3 * 33]); o.z = pk2(s[4 * 33], s[5 * 33]); o.w = pk2(s[6 * 33], s[7 * 33]);
        *(u32x4*)(WT + (size_t)(drow0 + n) * K + k0 + 8 * c) = o; }
    __builtin_amdgcn_wave_barrier();
}
__device__ __forceinline__ int map_gu(int n0) { return n0 < FF ? 256 * (n0 / 128) + (n0 % 128) : 256 * ((n0 - FF) / 128) + 128 + ((n0 - FF) % 128); }
__device__ __forceinline__ int map_ev(int n0) { return n0 < 512 ? 256 * (n0 / 128) + (n0 % 128) : (n0 < 1024 ? 256 * ((n0 - 512) / 128) + 128 + ((n0 - 512) % 128) : n0); }

__device__ __forceinline__ void block_transpose_item(const float* W, int ldw, int K, bf16_t* WT, int k0, int n0, int mapm, unsigned char* lds, int tid) {
    float* tile = (float*)lds;
    const int lane = tid & 63, wave = tid >> 6;
    f32x4 v[8];
#pragma unroll
    for (int rr = 0; rr < 8; ++rr) v[rr] = *(const f32x4*)(W + (size_t)(k0 + wave * 8 + rr) * ldw + n0 + 4 * lane);
    __syncthreads();
#pragma unroll
    for (int rr = 0; rr < 8; ++rr) *(f32x4*)(tile + (wave * 8 + rr) * 260 + 4 * lane) = v[rr];
    __syncthreads();
    const int n = tid & 255, half = tid >> 8; const float* tp = tile + (32 * half) * 260 + n;
    const int ng = n0 + n, n32 = ng & ~31; const int dn = (mapm == 1 ? map_gu(n32) : (mapm == 2 ? map_ev(n32) : n32)) + (ng & 31);
    bf16_t* op = WT + (size_t)dn * K + k0 + 32 * half;
#pragma unroll
    for (int q = 0; q < 4; ++q) { u32x4 o; o.x = pk2(tp[(8 * q + 0) * 260], tp[(8 * q + 1) * 260]); o.y = pk2(tp[(8 * q + 2) * 260], tp[(8 * q + 3) * 260]); o.z = pk2(tp[(8 * q + 4) * 260], tp[(8 * q + 5) * 260]); o.w = pk2(tp[(8 * q + 6) * 260], tp[(8 * q + 7) * 260]);
        *(u32x4*)(op + 8 * q) = o; }
}
constexpr int I_GU = 16 * 22, I_D = 44 * 4, I_EIN = 16 * 7, I_SQ = 16 * 4, I_OIN = 16 * 16;
__device__ __forceinline__ void conv_gu(const Ctx& C, unsigned char* wsb, int l, int f, int r, unsigned char* lds, int tid) { const int kb = r / 22, nb = r % 22;
    block_transpose_item(C.in(f ? 11 : 7) + (size_t)l * D * 2 * FF, 2 * FF, D, (bf16_t*)(wsb + WS_WGU) + (size_t)(l * 2 + f) * 5632 * D, 64 * kb, 256 * nb, 1, lds, tid); }
__device__ __forceinline__ void conv_d(const Ctx& C, unsigned char* wsb, int l, int f, int r, unsigned char* lds, int tid) { const int kb = r / 4, nb = r % 4;
    block_transpose_item(C.in(f ? 12 : 8) + (size_t)l * FF * D, D, FF, (bf16_t*)(wsb + WS_WD) + (size_t)(l * 2 + f) * D * FF, 64 * kb, 256 * nb, 0, lds, tid); }
__device__ __forceinline__ void convert_rest(const Ctx& C, unsigned char* lds, int vb, int VG) {
    const int tid = tid_opaque();
    unsigned char* wsb = C.ws();
    constexpr int NITEMS = 3 * I_GU + 3 * I_D + I_EIN + I_SQ + I_OIN + I_SQ;
    for (int it = vb; it < NITEMS; it += VG) {
        int r = it;
        if (r < 3 * I_GU) { const int mi = r / I_GU + 1; conv_gu(C, wsb, mi >> 1, mi & 1, r - (mi - 1) * I_GU, lds, tid); continue; }
        r -= 3 * I_GU;
        if (r < 3 * I_D) { const int mi = r / I_D + 1; conv_d(C, wsb, mi >> 1, mi & 1, r - (mi - 1) * I_D, lds, tid); continue; }
        r -= 3 * I_D;
        if (r < I_EIN) { const int kb = r / 7, nb = r % 7; block_transpose_item(C.in(13), EVIN, D, (bf16_t*)(wsb + WS_WEIN), 64 * kb, 256 * nb, 2, lds, tid); continue; }
        r -= I_EIN;
        if (r < I_SQ) { const int kb = r / 4, nb = r % 4; block_transpose_item(C.in(19), D, D, (bf16_t*)(wsb + WS_WEOUT), 64 * kb, 256 * nb, 0, lds, tid); continue; }
        r -= I_SQ;
        if (r < I_OIN) { const int kb = r / 16, nb = r % 16; block_transpose_item(C.in(20), ODIN, D, (bf16_t*)(wsb + WS_WOIN), 64 * kb, 256 * nb, 0, lds, tid); continue; }
        r -= I_OIN;
        { const int kb = r / 4, nb = r % 4; block_transpose_item(C.in(23), D, D, (bf16_t*)(wsb + WS_WOOUT), 64 * kb, 256 * nb, 0, lds, tid); }
    }
    __syncthreads();
}

__device__ __forceinline__ void phase_p0(const Ctx& C, unsigned char* lds, int G) {
    const int tid = tid_opaque(), lane = tid & 63, wave = tid >> 6;
    unsigned char* wsb = C.ws();
    float* sc = (float*)(lds + 81920);
    { const float* cc = C.in(1); const float* cx = C.in(3);
#pragma unroll
      for (int it = 0; it < 10; ++it) { const int i = tid + 512 * it; const int ci = i >> 10, k = i & 1023; const float v = ci < 4 ? cc[ci * D + k] : cx[k]; sc[i] = siluf_(v); } }
    __syncthreads();
    const int gw = blockIdx.x * 8 + wave, NGW = G * 8;
    float* MODS = (float*)(wsb + WS_MODS);
    const float* modw = C.in(4); const float* modb = C.in(5);
    for (int item = wave * G + (int)blockIdx.x; item < 2 * 36 * 16; item += NGW) {
        const int l = item / 576, r = item % 576, ch = r >> 4, ksl = r & 15, j0 = ch * 256 + 4 * lane, k0 = ksl * 64;
        const float* w = modw + (size_t)l * D * NMODC + (size_t)k0 * NMODC + j0;
        f32x4 a0 = {0.f, 0.f, 0.f, 0.f}, a1 = a0, a2 = a0, a3 = a0, a4 = a0;
#pragma unroll 16
        for (int kk = 0; kk < 64; ++kk) { const f32x4 wv = *(const f32x4*)(w + (size_t)kk * NMODC); const int k = k0 + kk;
            a0 += wv * sc[k]; a1 += wv * sc[D + k]; a2 += wv * sc[2 * D + k]; a3 += wv * sc[3 * D + k]; a4 += wv * sc[4 * D + k]; }
        if (ksl == 0) { const f32x4 bv = *(const f32x4*)(modb + l * NMODC + j0); a0 += bv; a1 += bv; a2 += bv; a3 += bv; a4 += bv; }
        float* mp = MODS + (size_t)(l * 5) * NMODC + j0;
#pragma unroll
        for (int e = 0; e < 4; ++e) { atomicAdd(mp + e, a0[e]); atomicAdd(mp + NMODC + e, a1[e]); atomicAdd(mp + 2 * NMODC + e, a2[e]); atomicAdd(mp + 3 * NMODC + e, a3[e]); atomicAdd(mp + 4 * NMODC + e, a4[e]); }
    }
    if (blockIdx.x == 0) { for (int i = tid; i < 1024; i += 512) { const int p = i >> 4, f = i & 15; const float inv = exp2f(-(float)f * (13.287712379549449f / 16.0f)); const float rev = (float)p * inv * 0.15915494309189535f;
            float* rp = (float*)(wsb + WS_ROPE); rp[i] = __builtin_amdgcn_cosf(rev); rp[1024 + i] = __builtin_amdgcn_sinf(rev); } }
    for (int it = blockIdx.x; it < I_GU + I_D; it += G) { if (it < I_GU) conv_gu(C, wsb, 0, 0, it, lds, tid); else conv_d(C, wsb, 0, 0, it - I_GU, lds, tid); }
    __syncthreads();
}

__device__ __forceinline__ void phase_p0b(const Ctx& C, unsigned char* lds, int G) {
    const int tid = tid_opaque(), lane = tid & 63, wave = tid >> 6;
    const int gw = blockIdx.x * 8 + wave, NGW = G * 8;
    unsigned char* wsb = C.ws();
    const float* MODS = (const float*)(wsb + WS_MODS);
    float* sh = (float*)lds;
#pragma unroll 20
    for (int it = 0; it < 60; ++it) { const int i = tid + 512 * it; const int inst = i / (5 * D), r = i % (5 * D), ci = r >> 10, kk = r & 1023; sh[i] = MODS[(size_t)((inst / 3) * 5 + ci) * NMODC + (3 * (inst % 3)) * D + kk]; }
    float* RS = (float*)(wsb + WS_RS); bf16_t* XN = (bf16_t*)(wsb + WS_XN);
    const float* xin = C.in(0); const float* cin = C.in(2); const float* g = C.in(6);
    for (int r0 = 2 * gw; r0 < M; r0 += 2 * NGW) {
        f32x4 v[2][4]; float ss[2];
#pragma unroll
        for (int q = 0; q < 2; ++q) { const int r = r0 + q; const float* xr = r < ML ? xin + (size_t)r * D : cin + (size_t)(r - ML) * D;
#pragma unroll
            for (int j = 0; j < 4; ++j) v[q][j] = *(const f32x4*)(xr + 4 * lane + 256 * j); }
#pragma unroll
        for (int q = 0; q < 2; ++q) { float t = 0.f;
#pragma unroll
            for (int j = 0; j < 4; ++j) t += (v[q][j][0] * v[q][j][0] + v[q][j][1] * v[q][j][1]) + (v[q][j][2] * v[q][j][2] + v[q][j][3] * v[q][j][3]);
            ss[q] = wave_sum(t); }
        const int ci = r0 < ML ? r0 >> 12 : 4; const float* scl = MODS + (size_t)ci * NMODC + D;
#pragma unroll
        for (int q = 0; q < 2; ++q) { const int r = r0 + q; if (lane == 0) RS[r] = ss[q];
#pragma unroll
            for (int j = 0; j < 4; ++j) { const int col = 4 * lane + 256 * j; const f32x4 y = v[q][j] * (*(const f32x4*)(g + col) * (*(const f32x4*)(scl + col) + 1.0f));
                u32x2 w; w.x = pk2(y[0], y[1]); w.y = pk2(y[2], y[3]); *(u32x2*)(XN + (size_t)r * D + col) = w; } }
    }
    __syncthreads();
    float* SB = (float*)(wsb + WS_SB);
    constexpr int C_GU = 88, C_EV = 28, C_OD = 64;
    constexpr int NCH = 4 * C_GU + C_EV + C_OD;
    for (int item = gw; item < NCH * 16; item += NGW) {
        const int ksl = item & 15; int ch = item >> 4; int inst, N, ldw, mapm; const float* W;
        if (ch < 4 * C_GU) { const int mi = ch / C_GU; ch -= mi * C_GU; const int l = mi >> 1, f = mi & 1; inst = l * 3 + 2 * f; N = 5632; ldw = 5632; mapm = 1; W = C.in(f ? 11 : 7) + (size_t)l * D * 5632; }
        else if (ch < 4 * C_GU + C_EV) { ch -= 4 * C_GU; inst = 1; N = EVIN; ldw = EVIN; mapm = 2; W = C.in(13); }
        else { ch -= 4 * C_GU + C_EV; inst = 4; N = ODN; ldw = ODIN; mapm = 0; W = C.in(20); }
        const int n = ch * 64 + lane, k0 = ksl * 64;
        const float* wp = W + (size_t)k0 * ldw + n; const float* shp = sh + inst * 5 * D + k0;
        float a0 = 0.f, a1 = 0.f, a2 = 0.f, a3 = 0.f, a4 = 0.f;
#pragma unroll 32
        for (int kk = 0; kk < 64; ++kk) { const float wv = wp[(size_t)kk * ldw]; a0 += shp[kk] * wv; a1 += shp[D + kk] * wv; a2 += shp[2 * D + kk] * wv; a3 += shp[3 * D + kk] * wv; a4 += shp[4 * D + kk] * wv; }
        const int n32 = n & ~31; const int dn = (mapm == 1 ? map_gu(n32) : (mapm == 2 ? map_ev(n32) : n32)) + (n & 31);
        float* sp = SB + (size_t)(inst * 5) * 5632 + dn;
        atomicAdd(sp, a0); atomicAdd(sp + 5632, a1); atomicAdd(sp + 2 * 5632, a2); atomicAdd(sp + 3 * 5632, a3); atomicAdd(sp + 4 * 5632, a4);
    }
    __syncthreads();
    convert_rest(C, lds, blockIdx.x, G);
}

__device__ __forceinline__ void phase_gates(const Ctx& C, unsigned char* lds, int G) {
    const int tid = tid_opaque(), lane = tid & 63, wave = tid >> 6, m16 = lane & 15, kg = lane >> 4;
    float* wgt = (float*)lds;
    { const float* wsrc = C.in(20);
#pragma unroll
      for (int it = 0; it < 32; ++it) { const int i = tid + 512 * it; const int k = i >> 4, j = i & 15; wgt[j * 1028 + k] = wsrc[(size_t)k * ODIN + ODN + j]; } }
    float* gst = (float*)(lds + 66048);
    float* sht = (float*)(lds + 66048 + 20480);
    { const float* MODS1 = ws_f(C, WS_MODS) + (size_t)5 * NMODC; const float* gp = C.in(9) + D;
#pragma unroll
      for (int it = 0; it < 10; ++it) { const int i = tid + 512 * it, ci = i >> 10, k = i & 1023; gst[i] = gp[k] * (MODS1[(size_t)ci * NMODC + 4 * D + k] + 1.0f); sht[i] = MODS1[(size_t)ci * NMODC + 3 * D + k]; } }
    __syncthreads();
    const int nskip = (G > 64 && 800 % G != 0) ? (800 % G) : 0;
    const int gw = ((int)blockIdx.x - nskip) * 8 + wave, NGW = (G - nskip) * 8;
    const float* MODS = ws_f(C, WS_MODS) + (size_t)5 * NMODC;
    const float* RS = ws_f(C, WS_RS) + (size_t)4 * M;
    float* GT = ws_f(C, WS_GATES);
    const float* xl = C.out(); const float* xc = ws_f(C, WS_XC); const float* g = C.in(9) + D; const float* bg = C.in(21);
    for (int rg = gw < 0 ? M / 16 : gw; rg < M / 16; rg += NGW) {
        const int r = rg * 16 + m16;
        const float* xr = r < ML ? xl + (size_t)r * D : xc + (size_t)(r - ML) * D;
        const int ci = r < ML ? r >> 12 : 4;
        const float rstd = __builtin_amdgcn_rsqf(RS[r] * (1.0f / 1024.0f) + EPS);
        const float* shf = sht + ci * D; const float* gsp = gst + ci * D;
        f32x4 acc = {0.f, 0.f, 0.f, 0.f};
#pragma unroll 16
        for (int k0 = 0; k0 < D; k0 += 16) { const int k = k0 + 4 * kg;
            const f32x4 hv = *(const f32x4*)(xr + k) * rstd * *(const f32x4*)(gsp + k) + *(const f32x4*)(shf + k);
            const f32x4 wv = *(const f32x4*)(wgt + m16 * 1028 + k);
            acc = __builtin_amdgcn_mfma_f32_16x16x4f32(hv[0], wv[0], acc, 0, 0, 0); acc = __builtin_amdgcn_mfma_f32_16x16x4f32(hv[1], wv[1], acc, 0, 0, 0);
            acc = __builtin_amdgcn_mfma_f32_16x16x4f32(hv[2], wv[2], acc, 0, 0, 0); acc = __builtin_amdgcn_mfma_f32_16x16x4f32(hv[3], wv[3], acc, 0, 0, 0); }
        const float bgv = bg[m16];
#pragma unroll
        for (int j = 0; j < 4; ++j) GT[(size_t)(rg * 16 + 4 * kg + j) * 16 + m16] = acc[j] + bgv;
    }
    __syncthreads();
}

template <int NSL> __device__ __forceinline__ void phase_ctx_fin(const Ctx& C, int G, float gcoef, const float* basec, size_t gate_off, const float* ng, size_t nscale_off, size_t rs_off) {
    const int tid = tid_opaque(), lane = tid & 63, wave = tid >> 6;
    const int gw = blockIdx.x * 8 + wave, NGW = G * 8;
    unsigned char* wsb = C.ws();
    const float* part = (const float*)(wsb + WS_PART); float* XCp = (float*)(wsb + WS_XC); bf16_t* XNp = (bf16_t*)(wsb + WS_XN); float* RSp = (float*)(wsb + rs_off);
    const float* gate = (const float*)(wsb + gate_off) + 4 * NMODC; const float* nsc = (const float*)(wsb + nscale_off) + 4 * NMODC;
    for (int r = gw; r < MC; r += NGW) {
        float ss = 0.f;
#pragma unroll
        for (int j = 0; j < 4; ++j) { const int col = 4 * lane + 256 * j; f32x4 a = {0.f, 0.f, 0.f, 0.f};
#pragma unroll
            for (int sl = 0; sl < NSL; ++sl) a += *(const f32x4*)(part + ((size_t)sl * MC + r) * D + col);
            const f32x4 x = *(const f32x4*)(basec + (size_t)r * D + col) + *(const f32x4*)(gate + col) * gcoef * a; *(f32x4*)(XCp + (size_t)r * D + col) = x;
            ss += (x[0] * x[0] + x[1] * x[1]) + (x[2] * x[2] + x[3] * x[3]);
            const f32x4 y = x * (*(const f32x4*)(ng + col) * (*(const f32x4*)(nsc + col) + 1.0f));
            u32x2 w; w.x = pk2(y[0], y[1]); w.y = pk2(y[2], y[3]); *(u32x2*)(XNp + (size_t)(ML + r) * D + col) = w; }
        ss = wave_sum(ss);
        if (lane == 0) RSp[ML + r] = ss;
    }
}
__device__ __forceinline__ void phase_hn(const Ctx& C, int G) {
    const int tid = tid_opaque(), lane = tid & 63, wave = tid >> 6;
    const int gw = blockIdx.x * 8 + wave, NGW = G * 8;
    const bf16_t* HF = ws_h(C, WS_HF); const bf16_t* HB = ws_h(C, WS_HB); bf16_t* HN = ws_h(C, WS_HN); const float* ngp = C.in(22);
    for (int r0 = 2 * gw; r0 < ML; r0 += 2 * NGW) {
        u32x2 a[2][4], b[2][4];
#pragma unroll
        for (int q = 0; q < 2; ++q)
#pragma unroll
            for (int hd = 0; hd < 4; ++hd) { const size_t o = (size_t)(r0 + q) * D + hd * 256 + 4 * lane; a[q][hd] = *(const u32x2*)(HF + o); b[q][hd] = *(const u32x2*)(HB + o); }
#pragma unroll
        for (int q = 0; q < 2; ++q)
#pragma unroll
            for (int hd = 0; hd < 4; ++hd) { const int col = hd * 256 + 4 * lane;
                f32x4 s = {bflo(a[q][hd].x) + bflo(b[q][hd].x), bfhi(a[q][hd].x) + bfhi(b[q][hd].x), bflo(a[q][hd].y) + bflo(b[q][hd].y), bfhi(a[q][hd].y) + bfhi(b[q][hd].y)};
                const float ss = wave_sum((s[0] * s[0] + s[1] * s[1]) + (s[2] * s[2] + s[3] * s[3]));
                const float rr = __builtin_amdgcn_rsqf(ss * (1.0f / 256.0f) + EPS);
                const f32x4 y = s * rr * *(const f32x4*)(ngp + col);
                u32x2 w; w.x = pk2(y[0], y[1]); w.y = pk2(y[2], y[3]); *(u32x2*)(HN + (size_t)(r0 + q) * D + col) = w; }
    }
}
__device__ __forceinline__ void phase_final(const Ctx& C, int G) {
    const int tid = tid_opaque(), lane = tid & 63, wave = tid >> 6;
    const int gw = blockIdx.x * 8 + wave, NGW = G * 8;
    const float* RS = ws_f(C, WS_RS) + (size_t)6 * M; float* xo = C.out(); const float* fn = C.in(24);
    for (int r0 = 2 * gw; r0 < ML; r0 += 2 * NGW) {
        f32x4 v[2][4]; float rstd[2];
#pragma unroll
        for (int q = 0; q < 2; ++q) { rstd[q] = __builtin_amdgcn_rsqf(RS[r0 + q] * (1.0f / 1024.0f) + EPS);
#pragma unroll
            for (int j = 0; j < 4; ++j) v[q][j] = *(const f32x4*)(xo + (size_t)(r0 + q) * D + 4 * lane + 256 * j); }
#pragma unroll
        for (int q = 0; q < 2; ++q)
#pragma unroll
            for (int j = 0; j < 4; ++j) { const int col = 4 * lane + 256 * j; *(f32x4*)(xo + (size_t)(r0 + q) * D + col) = v[q][j] * rstd[q] * *(const f32x4*)(fn + col); }
    }
}
__device__ __forceinline__ bf16x8 ld_bf16x8(const void* p) { return *(const bf16x8*)p; }
__device__ __forceinline__ void attn_unit(const Ctx& C, unsigned char* lds, int qrow0, int kvh, int hp, int nch, int kr0, int kr1, int kr2, int kr3, int kr4, int md0, int md1, int md2) {
    const int tid = tid_opaque(), lane = tid & 63, wave = tid >> 6, fr = lane & 15, fq = lane >> 4;
    const bf16_t* Q = ws_h(C, WS_Q); const bf16_t* KV = ws_h(C, WS_KV); bf16_t* MIXA = ws_h(C, WS_MIXA_E);
    unsigned char* Ks = lds;
    unsigned char* Vt = lds + 18432;
    const int g = wave >> 2, quarter = wave & 3, head = kvh * 4 + hp * 2 + g;
    bf16x8 qf[2][2];
#pragma unroll
    for (int qt = 0; qt < 2; ++qt)
#pragma unroll
        for (int ks = 0; ks < 2; ++ks) qf[qt][ks] = ld_bf16x8(Q + (size_t)(qrow0 + quarter * 32 + 16 * qt + fr) * 512 + head * 64 + 32 * ks + 8 * fq);
    const float sink2 = C.in(18)[head] * LOG2E;
    float mrun[2], lrun[2]; f32x4 O[2][4];
#pragma unroll
    for (int qt = 0; qt < 2; ++qt) { mrun[qt] = sink2; lrun[qt] = 1.f;
#pragma unroll
        for (int dt = 0; dt < 4; ++dt) O[qt][dt] = (f32x4){0.f, 0.f, 0.f, 0.f}; }
    u32x4 kreg[2], vreg[2];
#define ATT_FETCH(krow_) do { _Pragma("unroll") for (int i = 0; i < 2; ++i) { const int p = tid + 512 * i; \
            kreg[i] = *(const u32x4*)(KV + (size_t)((krow_) + (p >> 3)) * 256 + kvh * 64 + 8 * (p & 7)); \
            vreg[i] = *(const u32x4*)(KV + (size_t)((krow_) + (p & 127)) * 256 + 128 + kvh * 64 + 8 * (p >> 7)); } } while (0)
    ATT_FETCH(kr0);
    for (int c = 0; c < nch; ++c) {
        const int mode = c == 0 ? md0 : (c == 1 ? md1 : (c == 2 ? md2 : 0));
        __syncthreads();
#pragma unroll
        for (int i = 0; i < 2; ++i) { const int p = tid + 512 * i;
            *(u32x4*)(Ks + (p >> 3) * 144 + (p & 7) * 16) = kreg[i];
            const u32x4 vv = vreg[i];
            bf16_t* vt = (bf16_t*)(Vt + (8 * (p >> 7)) * 272) + (p & 127);
            vt[0 * 136] = (bf16_t)(vv.x & 0xffff); vt[1 * 136] = (bf16_t)(vv.x >> 16); vt[2 * 136] = (bf16_t)(vv.y & 0xffff); vt[3 * 136] = (bf16_t)(vv.y >> 16);
            vt[4 * 136] = (bf16_t)(vv.z & 0xffff); vt[5 * 136] = (bf16_t)(vv.z >> 16); vt[6 * 136] = (bf16_t)(vv.w & 0xffff); vt[7 * 136] = (bf16_t)(vv.w >> 16); }
        __syncthreads();
        if (c + 1 < nch) { const int krn = c == 0 ? kr1 : (c == 1 ? kr2 : (c == 2 ? kr3 : kr4)); ATT_FETCH(krn); }
        const int mlo = mode == 1 ? 0 : -1000, mhi = mode == 2 ? 0 : 1000;
#pragma unroll
        for (int qt = 0; qt < 2; ++qt) {
            f32x4 st[8];
#pragma unroll
            for (int kt = 0; kt < 8; ++kt) { st[kt] = (f32x4){0.f, 0.f, 0.f, 0.f};
#pragma unroll
                for (int ks = 0; ks < 2; ++ks) st[kt] = __builtin_amdgcn_mfma_f32_16x16x32_bf16(ld_bf16x8(Ks + (16 * kt + fr) * 144 + (32 * ks + 8 * fq) * 2), qf[qt][ks], st[kt], 0, 0, 0); }
            const int qoff = quarter * 32 + 16 * qt + fr;
            float mx = -INFINITY;
#pragma unroll
            for (int kt = 0; kt < 8; ++kt)
#pragma unroll
                for (int j = 0; j < 4; ++j) { const int rel = 16 * kt + 4 * fq + j - qoff;
                    st[kt][j] = (rel < mlo || rel > mhi) ? -INFINITY : st[kt][j];
                    mx = fmaxf(mx, st[kt][j]); }
            mx = fmaxf(mx, __shfl_xor(mx, 16)); mx = fmaxf(mx, __shfl_xor(mx, 32));
            const float mnew = fmaxf(mrun[qt], mx), alpha = exp2f(mrun[qt] - mnew);
            float rsum = 0.f;
#pragma unroll
            for (int kt = 0; kt < 8; ++kt)
#pragma unroll
                for (int j = 0; j < 4; ++j) { st[kt][j] = exp2f(st[kt][j] - mnew); rsum += st[kt][j]; }
            rsum += __shfl_xor(rsum, 16); rsum += __shfl_xor(rsum, 32);
            lrun[qt] = lrun[qt] * alpha + rsum; mrun[qt] = mnew;
#pragma unroll
            for (int dt = 0; dt < 4; ++dt) O[qt][dt] *= alpha;
#pragma unroll
            for (int kk = 0; kk < 4; ++kk) {
                u32x4 pw; pw.x = pk2(st[2 * kk][0], st[2 * kk][1]); pw.y = pk2(st[2 * kk][2], st[2 * kk][3]); pw.z = pk2(st[2 * kk + 1][0], st[2 * kk + 1][1]); pw.w = pk2(st[2 * kk + 1][2], st[2 * kk + 1][3]);
                const bf16x8 pb = __builtin_bit_cast(bf16x8, pw);
#pragma unroll
                for (int dt = 0; dt < 4; ++dt) {
                    const unsigned char* vp = Vt + (16 * dt + fr) * 272 + (32 * kk + 4 * fq) * 2;
                    const u32x2 lo = *(const u32x2*)vp, hi = *(const u32x2*)(vp + 32);
                    u32x4 vw; vw.x = lo.x; vw.y = lo.y; vw.z = hi.x; vw.w = hi.y;
                    O[qt][dt] = __builtin_amdgcn_mfma_f32_16x16x32_bf16(__builtin_bit_cast(bf16x8, vw), pb, O[qt][dt], 0, 0, 0);
                }
            }
            asm volatile("" ::: "memory"); __builtin_amdgcn_sched_barrier(0);
        }
    }
#pragma unroll
    for (int qt = 0; qt < 2; ++qt) { const float inv = 1.0f / lrun[qt]; const int row = qrow0 + quarter * 32 + 16 * qt + fr;
#pragma unroll
        for (int dt = 0; dt < 4; ++dt) { const f32x4 o = O[qt][dt] * inv; u32x2 w; w.x = pk2(o[0], o[1]); w.y = pk2(o[2], o[3]);
            *(u32x2*)(MIXA + (size_t)row * D + 512 + head * 64 + 16 * dt + 4 * fq) = w; } }
#undef ATT_FETCH
}

__device__ __forceinline__ void conv_unit(const Ctx& C, unsigned char* lds, int srow0, int slen, int t0) {
    const int tid = tid_opaque(), lane = tid & 63, wave = tid >> 6, c = tid;
    unsigned char* wsb = C.ws();
    const bf16_t* U = (const bf16_t*)(wsb + WS_U); bf16_t* MIXA = (bf16_t*)(wsb + WS_MIXA_E);
    float* yt = (float*)lds;
    const int cp = tid & 255, hp = tid >> 8;
    f32x2 w2[31];
    { const float* cw = C.in(14);
#pragma unroll
      for (int j = 0; j < 31; ++j) w2[j] = *(const f32x2*)(cw + j * 512 + 2 * cp); }
    const f32x2 bias2 = *(const f32x2*)(C.in(15) + 2 * cp);
    f32x2 win[32];
#pragma unroll
    for (int i = 0; i < 32; ++i) win[i] = (f32x2){0.f, 0.f};
    unsigned nw[2][32];
#pragma unroll
    for (int blk = 0; blk < 2; ++blk)
#pragma unroll
        for (int i = 0; i < 32; ++i) { const int il = 32 * blk + i, t = t0 - 15 + 32 * hp + il; nw[blk][i] = (il < 62 && t >= 0 && t < slen) ? *(const unsigned*)(U + (size_t)(srow0 + t) * 512 + 2 * cp) : 0u; }
#pragma unroll
    for (int blk = 0; blk < 2; ++blk) {
#pragma unroll
        for (int i = 0; i < 32; ++i) { win[i] = (f32x2){bflo(nw[blk][i]), bfhi(nw[blk][i])}; const int ol = 32 * blk + i - 30;
            if (ol >= 0 && ol < 32) { f32x2 a2 = bias2;
#pragma unroll
                for (int j = 0; j < 31; ++j) a2 += w2[j] * win[(i + 2 + j) & 31];
                *(f32x2*)(yt + (32 * hp + ol) * 512 + 2 * cp) = a2; } }
    }
    __syncthreads();
    { const float* lgp = C.in(16); const float* lbp = C.in(17);
      const f32x4 g0 = *(const f32x4*)(lgp + 4 * lane), g1 = *(const f32x4*)(lgp + 256 + 4 * lane), b0 = *(const f32x4*)(lbp + 4 * lane), b1 = *(const f32x4*)(lbp + 256 + 4 * lane);
#pragma unroll 2
      for (int r = 0; r < 8; ++r) { const int o = wave * 8 + r;
          const f32x4 y0 = *(const f32x4*)(yt + o * 512 + 4 * lane), y1 = *(const f32x4*)(yt + o * 512 + 256 + 4 * lane);
          const float s1 = wave_sum((y0[0] + y0[1]) + (y0[2] + y0[3]) + (y1[0] + y1[1]) + (y1[2] + y1[3]));
          const float mu = s1 * (1.0f / 512.0f); const f32x4 d0 = y0 - mu, d1 = y1 - mu;
          const float s2 = wave_sum((d0[0] * d0[0] + d0[1] * d0[1]) + (d0[2] * d0[2] + d0[3] * d0[3]) + (d1[0] * d1[0] + d1[1] * d1[1]) + (d1[2] * d1[2] + d1[3] * d1[3]));
          const float rstd = __builtin_amdgcn_rsqf(s2 * (1.0f / 512.0f) + EPS);
          const f32x4 v0 = d0 * rstd * g0 + b0, v1 = d1 * rstd * g1 + b1;
          bf16_t* op = MIXA + (size_t)(srow0 + t0 + o) * D;
          u32x2 wv; wv.x = pk2(siluf_(v0[0]), siluf_(v0[1])); wv.y = pk2(siluf_(v0[2]), siluf_(v0[3])); *(u32x2*)(op + 4 * lane) = wv;
          wv.x = pk2(siluf_(v1[0]), siluf_(v1[1])); wv.y = pk2(siluf_(v1[2]), siluf_(v1[3])); *(u32x2*)(op + 256 + 4 * lane) = wv; } }
}

__device__ __forceinline__ void phase_even_mix(const Ctx& C, unsigned char* lds, int G) {
    unsigned* qctr = (unsigned*)(C.ws() + WS_QCTR);
    volatile unsigned* qslot = (volatile unsigned*)(lds + LDS_BYTES - 384);
    for (;;) {
        __syncthreads();
        if (threadIdx.x == 0) *qslot = atomicAdd(qctr, 1u);
        __syncthreads();
        const int u = (int)*qslot;
        if (u >= 816) break;
        if (u < 544) {
            int qrow0, kvh, hp, nch, kr0, kr1, kr2 = 0, kr3 = 0, kr4 = 0, md0 = 0, md1 = 0, md2 = 0;
            if (u < 512) { const int b = u >> 7, qb = (u >> 2) & 31; kvh = (u >> 1) & 1; hp = u & 1; const int base = b * SEQ, c0 = ML + b * CTXL; qrow0 = base + qb * 128;
                if (qb == 0) { nch = 4; kr0 = base; kr1 = base + 128; kr2 = c0; kr3 = c0 + 128; md1 = 2; }
                else if (qb == 31) { nch = 4; kr0 = base + 30 * 128; kr1 = base + 31 * 128; kr2 = c0; kr3 = c0 + 128; md0 = 1; }
                else { nch = 5; kr0 = base + (qb - 1) * 128; kr1 = base + qb * 128; kr2 = base + (qb + 1) * 128; kr3 = c0; kr4 = c0 + 128; md0 = 1; md2 = 2; }
            } else { const int e = u - 512, b = e >> 3, hf = (e >> 1) & 1; kvh = (e >> 2) & 1; hp = e & 1; const int c0 = ML + b * CTXL; qrow0 = c0 + hf * 128; nch = 2; kr0 = c0; kr1 = c0 + 128; }
            attn_unit(C, lds, qrow0, kvh, hp, nch, kr0, kr1, kr2, kr3, kr4, md0, md1, md2);
        } else { const int e = u - 544; int s0, sl, t0;
            if (e < 256) { s0 = (e >> 6) * SEQ; sl = SEQ; t0 = (e & 63) * 64; } else { const int f = e - 256; s0 = ML + (f >> 2) * CTXL; sl = CTXL; t0 = (f & 3) * 64; }
            conv_unit(C, lds, s0, sl, t0);
            __syncthreads();
        }
    }
}
typedef short v4i16_t __attribute__((ext_vector_type(4)));
__device__ __forceinline__ s16x4 lds_tr16(const unsigned char* p) { return __builtin_bit_cast(s16x4, __builtin_amdgcn_ds_read_tr16_b64_v4i16((__attribute__((address_space(3))) v4i16_t*)p)); }
__device__ __forceinline__ void phase_scan(const Ctx& C, unsigned char* lds, int G) {
    const int tid = tid_opaque(), lane = tid & 63, wave = tid >> 6, fr = lane & 15, fq = lane >> 4;
    unsigned char* wsb = C.ws();
    const bf16_t* QB = (const bf16_t*)(wsb + WS_QKV); const bf16_t* KB = QB + (size_t)M * D; const bf16_t* VB = QB + (size_t)2 * M * D;
    const float* GT = (const float*)(wsb + WS_GATES);
    unsigned char* KT = lds;
    unsigned char* VT = lds + 69632;
    unsigned char* VW = lds + 78336;
    unsigned char* CB = lds + 91392;
    float* SC = (float*)(lds + 116736);
    const int qt = wave < 4 ? wave : 11 - wave;
    for (int unit = blockIdx.x; unit < 256; unit += G) {
        const int b = unit >> 6, h = (unit >> 4) & 3, dir = (unit >> 3) & 1, vs = unit & 7;
        bf16_t* HO = (bf16_t*)(wsb + (dir ? WS_HB : WS_HF));
        __syncthreads();
        for (int i = tid; i < (13056 + 25344) / 4; i += 512) ((unsigned*)VW)[i] = 0u;
        f32x4 Cacc[3][2];
#pragma unroll
        for (int a = 0; a < 3; ++a)
#pragma unroll
            for (int bb = 0; bb < 2; ++bb) Cacc[a][bb] = (f32x4){0.f, 0.f, 0.f, 0.f};
        float mstate = 0.f;
        u32x4 kreg[8]; u32x4 vreg; bf16x8 qn[8];
        float gi0 = 0.f, gf0 = 0.f, gi1 = 0.f, gf1 = 0.f;
#define STEP_R0(s) ((s) < 2 ? ML + b * CTXL + (dir ? 1 - (s) : (s)) * 128 : b * SEQ + (dir ? 33 - (s) : (s) - 2) * 128)
#define SROWX(r0_, l) ((r0_) + (dir ? 127 - (l) : (l)))
#define SCAN_FETCH(s) do { const int r0f = STEP_R0(s); \
            _Pragma("unroll") for (int i = 0; i < 8; ++i) { const int p = tid + 512 * i, l = p >> 5, c16 = p & 31; kreg[i] = *(const u32x4*)(KB + (size_t)SROWX(r0f, l) * D + h * 256 + 8 * c16); } \
            { const int l = tid & 127, c = tid >> 7; vreg = *(const u32x4*)(VB + (size_t)SROWX(r0f, l) * D + h * 256 + vs * 32 + 8 * c); } \
            if (wave == 0) { const int l0 = 2 * lane, l1 = l0 + 1; const float* g0p = GT + (size_t)SROWX(r0f, l0) * 16 + dir * 8 + h; const float* g1p = GT + (size_t)SROWX(r0f, l1) * 16 + dir * 8 + h; \
                gi0 = g0p[0]; gf0 = g0p[4]; gi1 = g1p[0]; gf1 = g1p[4]; } } while (0)
#define SCAN_FETCHQ(s) do { if ((s) >= 2) { const int r0f = STEP_R0(s); _Pragma("unroll") for (int ks = 0; ks < 8; ++ks) qn[ks] = ld_bf16x8(QB + (size_t)SROWX(r0f, 16 * qt + fr) * D + h * 256 + 32 * ks + 8 * fq); } } while (0)
#define SCAN_SCALARS(dst) do { float* scw = (dst); const int l0 = 2 * lane, l1 = l0 + 1; \
            const float lf0 = fminf(gf0, 0.f) - __logf(1.f + __expf(-fabsf(gf0))), lf1 = fminf(gf1, 0.f) - __logf(1.f + __expf(-fabsf(gf1))); \
            float S = lf0 + lf1; \
            _Pragma("unroll") for (int o = 1; o < 64; o <<= 1) { const float t_ = __shfl_up(S, o); if (lane >= o) S += t_; } \
            const float b1 = S, b0 = S - lf1, a0 = gi0 - b0, a1 = gi1 - b1; \
            float P = fmaxf(a0, a1); \
            _Pragma("unroll") for (int o = 1; o < 64; o <<= 1) { const float t_ = __shfl_up(P, o); if (lane >= o) P = fmaxf(P, t_); } \
            float ex = __shfl_up(P, 1); if (lane == 0) ex = -INFINITY; \
            const float pm0 = fmaxf(ex, a0), pm1 = P, PM = __shfl(P, 63), bend = __shfl(S, 63), mx = fmaxf(mstate, PM); \
            scw[l0] = a0; scw[l1] = a1; scw[128 + l0] = fmaxf(pm0, mstate); scw[128 + l1] = fmaxf(pm1, mstate); scw[256 + l0] = b0; scw[256 + l1] = b1; \
            scw[384 + l0] = __expf(a0 - mx); scw[384 + l1] = __expf(a1 - mx); \
            if (lane == 0) { scw[512] = __expf(mstate - mx); scw[513] = mstate; } \
            mstate = bend + mx; } while (0)
#pragma unroll
        for (int ks = 0; ks < 8; ++ks) qn[ks] = (bf16x8){0, 0, 0, 0, 0, 0, 0, 0};
        SCAN_FETCH(0); SCAN_FETCHQ(0);
        if (wave == 0) SCAN_SCALARS(SC);
        __syncthreads();
#pragma unroll 1
        for (int step = 0; step < 34; ++step) {
            const float* sc = SC + (step & 1) * 576;
            const int r0 = STEP_R0(step);
#pragma unroll
            for (int i = 0; i < 8; ++i) { const int p = tid + 512 * i, l = p >> 5, c16 = p & 31; *(u32x4*)(KT + l * 528 + c16 * 16) = kreg[i]; }
            { const int l = tid & 127, c = tid >> 7; const float we = sc[384 + l];
                bf16_t* vt = (bf16_t*)(VT + (8 * c) * 272) + l; bf16_t* vw = (bf16_t*)(VW + (8 * c) * 272) + l;
                vt[0 * 136] = (bf16_t)(vreg.x & 0xffff); vt[1 * 136] = (bf16_t)(vreg.x >> 16); vt[2 * 136] = (bf16_t)(vreg.y & 0xffff); vt[3 * 136] = (bf16_t)(vreg.y >> 16);
                vt[4 * 136] = (bf16_t)(vreg.z & 0xffff); vt[5 * 136] = (bf16_t)(vreg.z >> 16); vt[6 * 136] = (bf16_t)(vreg.w & 0xffff); vt[7 * 136] = (bf16_t)(vreg.w >> 16);
                const unsigned w0 = pk2(bflo(vreg.x) * we, bfhi(vreg.x) * we), w1 = pk2(bflo(vreg.y) * we, bfhi(vreg.y) * we), w2 = pk2(bflo(vreg.z) * we, bfhi(vreg.z) * we), w3 = pk2(bflo(vreg.w) * we, bfhi(vreg.w) * we);
                vw[0 * 136] = (bf16_t)(w0 & 0xffff); vw[1 * 136] = (bf16_t)(w0 >> 16); vw[2 * 136] = (bf16_t)(w1 & 0xffff); vw[3 * 136] = (bf16_t)(w1 >> 16);
                vw[4 * 136] = (bf16_t)(w2 & 0xffff); vw[5 * 136] = (bf16_t)(w2 >> 16); vw[6 * 136] = (bf16_t)(w3 & 0xffff); vw[7 * 136] = (bf16_t)(w3 >> 16);
                if (c == 0) ((bf16_t*)(VW + 32 * 272))[l] = (bf16_t)(pk2(we, 0.f) & 0xffff); }
            __syncthreads();
            if (step >= 2) {
                f32x4 st[8];
#pragma unroll
                for (int kt = 0; kt < 8; ++kt) st[kt] = (f32x4){0.f, 0.f, 0.f, 0.f};
#define ST_BLOCK(kt) if ((kt) <= qt) { const unsigned char* kb_ = KT + (16 * (kt) + fr) * 528 + 16 * fq; \
                    const bf16x8 k0_ = ld_bf16x8(kb_), k1_ = ld_bf16x8(kb_ + 64), k2_ = ld_bf16x8(kb_ + 128), k3_ = ld_bf16x8(kb_ + 192), k4_ = ld_bf16x8(kb_ + 256), k5_ = ld_bf16x8(kb_ + 320), k6_ = ld_bf16x8(kb_ + 384), k7_ = ld_bf16x8(kb_ + 448); \
                    f32x4 s_ = st[kt]; \
                    s_ = __builtin_amdgcn_mfma_f32_16x16x32_bf16(k0_, qn[0], s_, 0, 0, 0); s_ = __builtin_amdgcn_mfma_f32_16x16x32_bf16(k1_, qn[1], s_, 0, 0, 0); \
                    s_ = __builtin_amdgcn_mfma_f32_16x16x32_bf16(k2_, qn[2], s_, 0, 0, 0); s_ = __builtin_amdgcn_mfma_f32_16x16x32_bf16(k3_, qn[3], s_, 0, 0, 0); \
                    s_ = __builtin_amdgcn_mfma_f32_16x16x32_bf16(k4_, qn[4], s_, 0, 0, 0); s_ = __builtin_amdgcn_mfma_f32_16x16x32_bf16(k5_, qn[5], s_, 0, 0, 0); \
                    s_ = __builtin_amdgcn_mfma_f32_16x16x32_bf16(k6_, qn[6], s_, 0, 0, 0); s_ = __builtin_amdgcn_mfma_f32_16x16x32_bf16(k7_, qn[7], s_, 0, 0, 0); st[kt] = s_; }
                ST_BLOCK(0) ST_BLOCK(1) ST_BLOCK(2) ST_BLOCK(3) ST_BLOCK(4) ST_BLOCK(5) ST_BLOCK(6) ST_BLOCK(7)
#undef ST_BLOCK
                const int q = 16 * qt + fr; const float Mqq = sc[128 + q];
                float dsum = 0.f;
#pragma unroll
                for (int kt = 0; kt < 8; ++kt) { if (kt <= qt) { const f32x4 av = *(const f32x4*)(sc + 16 * kt + 4 * fq);
#pragma unroll
                        for (int j = 0; j < 4; ++j) { const int key = 16 * kt + 4 * fq + j; const float wgt = key <= q ? __expf(av[j] - Mqq) : 0.f; st[kt][j] *= wgt; dsum += st[kt][j]; } } }
                dsum += __shfl_xor(dsum, 16); dsum += __shfl_xor(dsum, 32);
                f32x4 o1[2], cq[3];
#pragma unroll
                for (int vt = 0; vt < 2; ++vt) o1[vt] = (f32x4){0.f, 0.f, 0.f, 0.f};
#pragma unroll
                for (int vt = 0; vt < 3; ++vt) cq[vt] = (f32x4){0.f, 0.f, 0.f, 0.f};
#pragma unroll
                for (int kk = 0; kk < 4; ++kk) { if (2 * kk <= qt) {
                        u32x4 pw; pw.x = pk2(st[2 * kk][0], st[2 * kk][1]); pw.y = pk2(st[2 * kk][2], st[2 * kk][3]); pw.z = pk2(st[2 * kk + 1][0], st[2 * kk + 1][1]); pw.w = pk2(st[2 * kk + 1][2], st[2 * kk + 1][3]);
                        const bf16x8 pb = __builtin_bit_cast(bf16x8, pw);
#pragma unroll
                        for (int vt = 0; vt < 2; ++vt) { const unsigned char* vp = VT + (16 * vt + fr) * 272 + (32 * kk + 4 * fq) * 2;
                            const u32x2 lo = *(const u32x2*)vp, hi = *(const u32x2*)(vp + 32); u32x4 vw; vw.x = lo.x; vw.y = lo.y; vw.z = hi.x; vw.w = hi.y;
                            o1[vt] = __builtin_amdgcn_mfma_f32_16x16x32_bf16(__builtin_bit_cast(bf16x8, vw), pb, o1[vt], 0, 0, 0); } } }
#pragma unroll
                for (int kh = 0; kh < 2; ++kh) { bf16x8 cf[4][3];
#pragma unroll
                    for (int k4 = 0; k4 < 4; ++k4)
#pragma unroll
                        for (int vt = 0; vt < 3; ++vt) cf[k4][vt] = ld_bf16x8(CB + (16 * vt + fr) * 528 + (32 * (4 * kh + k4) + 8 * fq) * 2);
#pragma unroll
                    for (int k4 = 0; k4 < 4; ++k4)
#pragma unroll
                        for (int vt = 0; vt < 3; ++vt) cq[vt] = __builtin_amdgcn_mfma_f32_16x16x32_bf16(cf[k4][vt], qn[4 * kh + k4], cq[vt], 0, 0, 0); }
                const float nq = __shfl(cq[2][0], fr);
                const float winter = __expf(sc[513] - Mqq);
                const float den = dsum + winter * nq, flo = __expf(-sc[256 + q] - Mqq);
                const float inv = 1.0f / fmaxf(fabsf(den), flo);
                bf16_t* hp = HO + (size_t)SROWX(r0, q) * D + h * 256 + vs * 32 + 4 * fq;
#pragma unroll
                for (int vt = 0; vt < 2; ++vt) { const f32x4 hv = (o1[vt] + cq[vt] * winter) * inv; u32x2 w; w.x = pk2(hv[0], hv[1]); w.y = pk2(hv[2], hv[3]); *(u32x2*)(hp + 16 * vt) = w; }
            }
            if (step + 1 < 34) { SCAN_FETCH(step + 1); SCAN_FETCHQ(step + 1); }
            if (wave == 0 && step + 1 < 34) SCAN_SCALARS(SC + ((step + 1) & 1) * 576);
            { const float decay = sc[512];
#pragma unroll
                for (int a = 0; a < 3; ++a)
#pragma unroll
                    for (int bb = 0; bb < 2; ++bb) Cacc[a][bb] *= decay;
                const int qp = (lane & 15) >> 2, pp = lane & 3;
#pragma unroll
                for (int lh = 0; lh < 2; ++lh) {
                    bf16x8 av[2][3], bw[2][2];
#pragma unroll
                    for (int l2 = 0; l2 < 2; ++l2) { const int ls = 2 * lh + l2;
#pragma unroll
                        for (int vt = 0; vt < 3; ++vt) av[l2][vt] = ld_bf16x8(VW + (16 * vt + fr) * 272 + (32 * ls + 8 * fq) * 2);
#pragma unroll
                        for (int kdt = 0; kdt < 2; ++kdt) { const unsigned char* tp = KT + (32 * ls + 8 * fq + qp) * 528 + (16 * (2 * wave + kdt) + 4 * pp) * 2;
                            const s16x4 t0 = lds_tr16(tp), t1 = lds_tr16(tp + 4 * 528);
                            bw[l2][kdt] = (bf16x8){t0[0], t0[1], t0[2], t0[3], t1[0], t1[1], t1[2], t1[3]}; } }
#pragma unroll
                    for (int l2 = 0; l2 < 2; ++l2)
#pragma unroll
                        for (int vt = 0; vt < 3; ++vt)
#pragma unroll
                            for (int kdt = 0; kdt < 2; ++kdt) Cacc[vt][kdt] = __builtin_amdgcn_mfma_f32_16x16x32_bf16(av[l2][vt], bw[l2][kdt], Cacc[vt][kdt], 0, 0, 0);
                } }
            __syncthreads();
#pragma unroll
            for (int vt = 0; vt < 3; ++vt)
#pragma unroll
                for (int kdt = 0; kdt < 2; ++kdt)
#pragma unroll
                    for (int j = 0; j < 4; ++j) *((bf16_t*)(CB + (16 * vt + 4 * fq + j) * 528) + 32 * wave + 16 * kdt + fr) = (bf16_t)(pk2(Cacc[vt][kdt][j], 0.f) & 0xffff);
        }
#undef STEP_R0
#undef SROWX
#undef SCAN_FETCH
#undef SCAN_SCALARS
#undef SCAN_FETCHQ
    }
}
#define LAS __attribute__((address_space(3)))
#define XB_TMO      128
#define XB_XCNT(j)  (256  + 64 * (j))
#define XB_XSUB(j)  (1280 + 64 * (j))
#define XB_XGEN(j)  (2304 + 64 * (j))
#define XB_TOP      3328
#define XB_TOPGEN   3392
#define XCD_BAR_WORDS 3456
#define XB_SPIN_CAP (1u << 18)

__device__ __forceinline__ unsigned xb_ld(unsigned* p)              { return __hip_atomic_load(p, __ATOMIC_RELAXED, __HIP_MEMORY_SCOPE_AGENT); }
__device__ __forceinline__ unsigned xb_add(unsigned* p, unsigned v) { return __hip_atomic_fetch_add(p, v, __ATOMIC_RELAXED, __HIP_MEMORY_SCOPE_AGENT); }
__device__ __forceinline__ unsigned xb_xcc_id() { return (unsigned)__builtin_amdgcn_s_getreg((3 << 11) | 20) & 0xFu; }
#define XB_SPIN(cond, bar) do { unsigned _sp = 0; while (cond) { __builtin_amdgcn_s_sleep(1); \
    if ((++_sp & 255u) == 0u) { if (xb_ld(&(bar)[XB_TMO])) break; if (_sp > XB_SPIN_CAP) { atomicAdd(&(bar)[XB_TMO], 1u); break; } } } } while (0)

struct XcdBarrier {
    unsigned* bar; unsigned x;
    volatile LAS unsigned* st;
};

__device__ __forceinline__ XcdBarrier xcd_barrier_post(unsigned* bar, volatile LAS unsigned* st) {
    XcdBarrier b; b.bar = bar; b.x = xb_xcc_id(); b.st = st;
    if (threadIdx.x == 0) (void)xb_add(&bar[XB_XCNT(b.x)], 1u);
    return b;
}
__device__ __forceinline__ void xcd_barrier_complete(unsigned* bar, unsigned x, unsigned& nloc, unsigned& nx) {
    const unsigned G = gridDim.x * gridDim.y * gridDim.z;
    unsigned sum, cnt, mine, sp = 0u;
    for (;;) {
        sum = 0u; cnt = 0u; mine = 0u;
#pragma unroll
        for (unsigned j = 0; j < 16; ++j) { const unsigned c = xb_ld(&bar[XB_XCNT(j)]); sum += c; cnt += (c > 0u) ? 1u : 0u; mine = (j == x) ? c : mine; }
        if (sum == G) break;
        __builtin_amdgcn_s_sleep(1);
        if ((++sp & 255u) == 0u) { if (xb_ld(&bar[XB_TMO])) break; if (sp > XB_SPIN_CAP) { atomicAdd(&bar[XB_TMO], 1u); break; } }
    }
    nloc = mine > 0u ? mine : 1u; nx = cnt > 0u ? cnt : 1u;
}

__device__ __forceinline__ void xcd_barrier(const XcdBarrier& b) {
    asm volatile("s_waitcnt vmcnt(0)" ::: "memory");
    __syncthreads();
    if (threadIdx.x == 0) {
        unsigned* bar = b.bar;
        __builtin_amdgcn_s_waitcnt(0);
        unsigned nloc = b.st[0], nx = b.st[1];
        if (nloc == 0u) { xcd_barrier_complete(bar, b.x, nloc, nx); b.st[0] = nloc; b.st[1] = nx; }
        const unsigned old = xb_add(&bar[XB_XSUB(b.x)], 1u);
        const unsigned gen = old / nloc;
        if (old + 1u == (gen + 1u) * nloc) {
            __builtin_amdgcn_fence(__ATOMIC_RELEASE, "agent");
            asm volatile("s_waitcnt vmcnt(0)" ::: "memory");
            const unsigned og = xb_add(&bar[XB_TOP], 1u);
            const unsigned tg = og / nx;
            if (og + 1u == (tg + 1u) * nx) xb_add(&bar[XB_TOPGEN], 1u);
            else XB_SPIN(xb_ld(&bar[XB_TOPGEN]) == tg, bar);
            __builtin_amdgcn_fence(__ATOMIC_ACQUIRE, "agent");
            xb_add(&bar[XB_XGEN(b.x)], 1u);
            asm volatile("s_waitcnt vmcnt(0)" ::: "memory");
        } else {
            XB_SPIN(xb_ld(&bar[XB_XGEN(b.x)]) == gen, bar);
            __builtin_amdgcn_fence(__ATOMIC_ACQUIRE, "agent");
            asm volatile("s_waitcnt vmcnt(0)" ::: "memory");
        }
    }
    __syncthreads();
}

struct Args { const float* in[25]; float* out; unsigned char* ws; };
#define GEMM_PHASE(EPI, g, S, E) pg8::gemm_phase<EPI, pg8::Order, true, true>((PG8_LAS unsigned char*)lds, g, S, E)
__global__ void __launch_bounds__(512, 2) fwd_megakernel(Args args) {
    extern __shared__ __attribute__((aligned(16))) unsigned char lds[];
    cg::grid_group grid = cg::this_grid();
    Ctx C; C.tab = lds + LDS_BYTES - 256;
    if (threadIdx.x == 0) {
#pragma unroll
        for (int i = 0; i < 25; ++i) *(const float**)(C.tab + 8 * i) = args.in[i];
        *(float**)(C.tab + 8 * 25) = args.out; *(unsigned char**)(C.tab + 8 * 26) = args.ws; }
    if (threadIdx.x < 2) ((volatile LAS unsigned*)(lds + LDS_BYTES - 512))[threadIdx.x] = 0u;
    __syncthreads();
    const int G = gridDim.x, bid = blockIdx.x;
    (void)xcd_barrier_post((unsigned*)(args.ws + WS_BAR), (volatile LAS unsigned*)(lds + LDS_BYTES - 512));
#define GSYNC() do { XcdBarrier xb_; xb_.bar = (unsigned*)(C.ws() + WS_BAR); xb_.x = xb_xcc_id(); xb_.st = (volatile LAS unsigned*)(lds + LDS_BYTES - 512); xcd_barrier(xb_); } while (0)
#define WF(off) ((float*)(w + (off)))
#define WH(off) ((bf16_t*)(w + (off)))
    phase_p0(C, lds, G);
    if (args.ws == nullptr) grid.sync();
    GSYNC();
    phase_p0b(C, lds, G);
    GSYNC();
#pragma unroll
    for (int l = 0; l < 2; ++l) {
        const size_t mods_l = WS_MODS + (size_t)l * 5 * NMODC * 4;
        { unsigned char* w = C.ws();
          pg8::Gemm g{WH(WS_XN), WH(WS_WGU + (size_t)(l * 2 + 0) * 5632 * D * 2), M, 5632, D}; pg8::Order S; S.init(M, 5632, D, G, bid);
          pg8::EpiFFNUp E{WF(WS_RS + (size_t)(l * 3 + 0) * M * 4), WF(WS_SB + (size_t)((l * 3 + 0) * 5) * 5632 * 4), WH(WS_ACT)}; GEMM_PHASE(pg8::EpiFFNUp, g, S, E); }
        GSYNC();
        { unsigned char* w = C.ws(); float* xo = C.out();
          pg8::Gemm g{WH(WS_ACT), WH(WS_WD + (size_t)(l * 2 + 0) * D * FF * 2), M, D, FF}; pg8::Order S; S.init(ML, D, FF, G, bid, 176, 64, 0, 4, 11);
          pg8::EpiResid<1> E{l == 0 ? C.in(0) : xo, l == 0 ? C.in(2) : WF(WS_XC), xo, WF(WS_XC), WF(mods_l + 2 * D * 4), C.in(9) + l * D, WF(mods_l + 4 * D * 4), WH(WS_XN), WF(WS_RS + (size_t)(l * 3 + 1) * M * 4), WF(WS_PART)};
          GEMM_PHASE(pg8::EpiResid<1>, g, S, E); }
        GSYNC();
        { const float* bc = l == 0 ? C.in(2) : (const float*)(C.ws() + WS_XC); phase_ctx_fin<11>(C, G, 0.5f, bc, mods_l + 2 * D * 4, C.in(9) + l * D, mods_l + 4 * D * 4, WS_RS + (size_t)(l * 3 + 1) * M * 4); GSYNC(); }
        if (l == 0) {
            { unsigned char* w = C.ws();
              pg8::Gemm g{WH(WS_XN), WH(WS_WEIN), M, EVIN, D}; pg8::Order S; S.init(M, EVIN, D, G, bid);
              pg8::EpiEvenIn E{WF(WS_RS + (size_t)1 * M * 4), WF(WS_SB + (size_t)(1 * 5) * 5632 * 4), WF(WS_ROPE), WF(WS_ROPE + 4096), WH(WS_U), WH(WS_Q), WH(WS_KV)};
              GEMM_PHASE(pg8::EpiEvenIn, g, S, E); }
            GSYNC();
            phase_even_mix(C, lds, G);
            GSYNC();
        } else {
            phase_gates(C, lds, G);
            { unsigned char* w = C.ws();
              pg8::Gemm g{WH(WS_XN), WH(WS_WOIN), M, 3072, D}; pg8::Order S; S.init(ML, 3072, D, G, bid, 32, 64, 4, 8, 1);
              pg8::EpiOddIn E{WF(WS_RS + (size_t)4 * M * 4), WF(WS_SB + (size_t)(4 * 5) * 5632 * 4), WH(WS_QKV)}; GEMM_PHASE(pg8::EpiOddIn, g, S, E); }
            GSYNC();
            phase_scan(C, lds, G);
            GSYNC();
            phase_hn(C, G);
            GSYNC();
            { unsigned char* w = C.ws();
              pg8::Gemm g{WH(WS_XN), WH(WS_WOIN + (size_t)3072 * D * 2), ML, D, D}; pg8::Order S; S.init(ML, D, D, G, bid);
              pg8::EpiOddGate E{WF(WS_RS + (size_t)4 * M * 4), WF(WS_SB + (size_t)(4 * 5) * 5632 * 4), WH(WS_HN), WH(WS_MIXA_O)}; GEMM_PHASE(pg8::EpiOddGate, g, S, E); }
            GSYNC();
        }
        const int Mr = l == 0 ? M : ML;
        { unsigned char* w = C.ws(); float* xo = C.out();
          pg8::Gemm g{WH(l == 0 ? WS_MIXA_E : WS_MIXA_O), WH(l == 0 ? WS_WEOUT : WS_WOOUT), Mr, D, D}; pg8::Order S; S.init(ML, D, D, G, bid, l == 0 ? 64 : 0, 64, 0, 4, 4);
          pg8::EpiResid<2> E{xo, WF(WS_XC), xo, WF(WS_XC), WF(mods_l + 5 * D * 4), C.in(10) + l * D, WF(mods_l + 7 * D * 4), WH(WS_XN), WF(WS_RS + (size_t)(l * 3 + 2) * M * 4), l == 0 ? WF(WS_PART) : nullptr};
          GEMM_PHASE(pg8::EpiResid<2>, g, S, E); }
        GSYNC();
        if (l == 0) { phase_ctx_fin<4>(C, G, 1.0f, (const float*)(C.ws() + WS_XC), mods_l + 5 * D * 4, C.in(10) + l * D, mods_l + 7 * D * 4, WS_RS + (size_t)(l * 3 + 2) * M * 4); GSYNC(); }
        { unsigned char* w = C.ws();
          pg8::Gemm g{WH(WS_XN), WH(WS_WGU + (size_t)(l * 2 + 1) * 5632 * D * 2), Mr, 5632, D}; pg8::Order S; S.init(Mr, 5632, D, G, bid);
          pg8::EpiFFNUp E{WF(WS_RS + (size_t)(l * 3 + 2) * M * 4), WF(WS_SB + (size_t)((l * 3 + 2) * 5) * 5632 * 4), WH(WS_ACT)}; GEMM_PHASE(pg8::EpiFFNUp, g, S, E); }
        GSYNC();
        { unsigned char* w = C.ws(); float* xo = C.out();
          pg8::Gemm g{WH(WS_ACT), WH(WS_WD + (size_t)(l * 2 + 1) * D * FF * 2), Mr, D, FF}; pg8::Order S; S.init(ML, D, FF, G, bid, l == 0 ? 176 : 0, 64, 0, 4, 11);
          pg8::EpiResid<1> E{xo, WF(WS_XC), xo, WF(WS_XC), WF(mods_l + 8 * D * 4), l == 0 ? C.in(6) + D : nullptr, WF(WS_MODS + (size_t)5 * NMODC * 4 + 1 * D * 4), WH(WS_XN), WF(WS_RS + (size_t)(l == 0 ? 3 : 6) * M * 4), l == 0 ? WF(WS_PART) : nullptr};
          GEMM_PHASE(pg8::EpiResid<1>, g, S, E); }
        GSYNC();
        if (l == 0) { phase_ctx_fin<11>(C, G, 0.5f, (const float*)(C.ws() + WS_XC), mods_l + 8 * D * 4, C.in(6) + D, WS_MODS + (size_t)5 * NMODC * 4 + 1 * D * 4, WS_RS + (size_t)3 * M * 4); GSYNC(); }
    }
    phase_final(C, G);
}

extern "C" void kernel_launch(void* const* d_in, const int* in_sizes, int n_in, void* d_out, int out_size, void* d_ws, size_t ws_size, hipStream_t stream) {
    static int grid = 0;
    if (grid == 0) {
        if (n_in != 25 || ws_size < WS_END) { fprintf(stderr, "kernel_launch: unexpected n_in %d / ws_size %zu (need %zu)\n", n_in, ws_size, (size_t)WS_END); grid = -1; return; }
        int dev = 0, cus = 0, per_cu = 0;
        hipGetDevice(&dev);
        hipDeviceGetAttribute(&cus, hipDeviceAttributeMultiprocessorCount, dev);
        hipFuncSetAttribute((const void*)fwd_megakernel, hipFuncAttributeMaxDynamicSharedMemorySize, LDS_BYTES);
        if (hipOccupancyMaxActiveBlocksPerMultiprocessor(&per_cu, (const void*)fwd_megakernel, 512, LDS_BYTES) != hipSuccess || per_cu < 1) per_cu = 1;
        (void)hipGetLastError();
        grid = cus * per_cu;
    }
    if (grid < 0) return;
    (void)hipMemsetAsync(d_ws, 0, 4 * MiB, stream);
    Args a{};
    for (int i = 0; i < 25; ++i) a.in[i] = (const float*)d_in[i];
    a.out = (float*)d_out; a.ws = (unsigned char*)d_ws;
    void* kargs[] = {&a};
    hipError_t e = hipLaunchCooperativeKernel((const void*)fwd_megakernel, dim3(grid), dim3(512), kargs, LDS_BYTES, stream);
    if (e != hipSuccess) fprintf(stderr, "cooperative launch failed: %s (grid %d)\n", hipGetErrorString(e), grid);
}
```

```cpp
#include <hip/hip_runtime.h>
#include <hip/hip_cooperative_groups.h>
#include <cstdio>
#include <cstdint>
namespace cg = cooperative_groups;
typedef unsigned short bf16_t;
typedef short bf16x8 __attribute__((ext_vector_type(8)));
typedef short s16x4 __attribute__((ext_vector_type(4)));
typedef float f32x4 __attribute__((ext_vector_type(4)));
typedef float f32x2 __attribute__((ext_vector_type(2)));
typedef unsigned u32x4 __attribute__((ext_vector_type(4)));
typedef unsigned u32x2 __attribute__((ext_vector_type(2)));
typedef __bf16 bf16x2_t __attribute__((ext_vector_type(2)));
__device__ __forceinline__ unsigned pk2(float lo, float hi) { f32x2 v = {lo, hi}; bf16x2_t b = __builtin_convertvector(v, bf16x2_t); return __builtin_bit_cast(unsigned, b); }
__device__ __forceinline__ float bflo(unsigned u) { return __uint_as_float(u << 16); }
__device__ __forceinline__ float bfhi(unsigned u) { return __uint_as_float(u & 0xffff0000u); }
__device__ __forceinline__ float bf2f(bf16_t u) { return __uint_as_float(((unsigned)u) << 16); }
__device__ __forceinline__ float wave_sum(float v) {
#pragma unroll
    for (int o = 1; o < 64; o <<= 1) v += __shfl_xor(v, o);
    return v;
}
__device__ __forceinline__ float sigmoidf_(float x) { return __builtin_amdgcn_rcpf(1.f + __expf(-x)); }
__device__ __forceinline__ float siluf_(float x) { return x * sigmoidf_(x); }

__device__ __forceinline__ int tid_opaque() { int t = threadIdx.x; asm volatile("" : "+v"(t)); return t; }
constexpr int D = 1024, NB = 4, SEQ = 4096, CTXL = 256, ML = NB * SEQ, MC = NB * CTXL, M = ML + MC, FF = 2816, NMODC = 9 * D;
constexpr int EVIN = 1792, ODIN = 4112, ODN = 4096;
constexpr float EPS = 1e-6f;
constexpr float QSCALE = 0.125f * 1.4426950408889634f;
constexpr float LOG2E = 1.4426950408889634f;
constexpr size_t MiB = 1u << 20;
constexpr size_t WS_MODS = 0;
constexpr size_t WS_SB = 512 * 1024;
constexpr size_t WS_RS = 1536 * 1024;
constexpr size_t WS_GATES = 2 * MiB;
constexpr size_t WS_ROPE = 2 * MiB + 1536 * 1024;
constexpr size_t WS_BAR = 3 * MiB + 768 * 1024;
constexpr size_t WS_QCTR = 3 * MiB + 896 * 1024;
constexpr size_t WS_XC = 4 * MiB;
constexpr size_t WS_WGU = 8 * MiB;
constexpr size_t WS_WD = WS_WGU + 44 * MiB;
constexpr size_t WS_WEIN = WS_WD + 22 * MiB;
constexpr size_t WS_WEOUT = WS_WEIN + 3 * MiB + 512 * 1024;
constexpr size_t WS_WOIN = WS_WEOUT + 2 * MiB;
constexpr size_t WS_WOOUT = WS_WOIN + 8 * MiB;
constexpr size_t WS_XN = 90 * MiB;
constexpr size_t WS_BIG = 124 * MiB;
static_assert(WS_WOOUT + 2 * MiB <= WS_XN, "weights fit");
constexpr size_t WS_ACT = WS_BIG;
constexpr size_t WS_U = WS_BIG;
constexpr size_t WS_Q = WS_BIG + 17 * MiB;
constexpr size_t WS_KV = WS_BIG + 34 * MiB;
constexpr size_t WS_MIXA_E = WS_BIG + 43 * MiB;
constexpr size_t WS_QKV = WS_BIG;
constexpr size_t WS_HF = WS_BIG + 102 * MiB;
constexpr size_t WS_HB = WS_BIG + 134 * MiB;
constexpr size_t WS_HN = WS_QKV;
constexpr size_t WS_MIXA_O = WS_QKV + 34 * MiB;
constexpr size_t WS_PART = WS_BIG + 94 * MiB;
constexpr size_t WS_END = WS_BIG + 166 * MiB;
constexpr size_t WS_SCG = WS_END;
constexpr size_t WS_END2 = WS_SCG + (size_t)256 * 34 * 384 * 4;
constexpr int LDS_BYTES = 147456;
namespace pg8 {
#define PG8_LAS __attribute__((address_space(3)))
typedef unsigned short bf16_t;
typedef short bf16x8 __attribute__((ext_vector_type(8)));
typedef float f32x4 __attribute__((ext_vector_type(4)));
typedef unsigned u32x4 __attribute__((ext_vector_type(4)));
constexpr int BM = 256, BK = 64, HALF = 128, HTB = HALF * BK * 2  , STAGE_BYTES = 8 * HTB, NXCD = 8, WGM = 8;

__host__ __device__ __forceinline__ int lds_byte(int r, int c) { const int st = (r >> 4) * 2 + (c >> 5), rr = r & 15, cc = c & 31, ob = rr * 64 + cc * 2; return st * 1024 + (ob ^ (((ob >> 9) & 1) << 5)); }
__host__ __device__ __forceinline__ void stage_rc(int b, int& R, int& C) { const int st = b / 1024, sb = b % 1024, swz = sb ^ (((sb >> 9) & 1) << 5); R = (st >> 1) * 16 + swz / 64; C = (st & 1) * 32 + (swz % 64) / 2; }
__host__ __device__ __forceinline__ int perm32(int rho) { const int n = rho >> 4, i = rho & 15; return 8 * (i >> 2) + 4 * n + (i & 3); }

struct Unit { int pm, pn, k0t, ntu; };
struct Gemm { const bf16_t* A; const bf16_t* Bt; int M, N, K; };

struct StaticOrder {
    int nM, nN, nwg, G, c;
    __host__ __device__ void init(int M, int N, int G_, int c_) { nM = M / BM; nN = N / BM; nwg = nM * nN; G = G_; c = c_; }
    __host__ __device__ bool next(int i, Unit& u) const {
        const long L = (long)i * G + c; if (L >= nwg) return false;
        int wgid = (int)L; { const int q = nwg / NXCD, r = nwg % NXCD, xcd = wgid % NXCD, off = wgid / NXCD; wgid = (xcd < r ? xcd * (q + 1) : r * (q + 1) + (xcd - r) * q) + off; }
        const int nig = WGM * nN, gid = wgid / nig, fm = gid * WGM, gsz = (nM - fm) < WGM ? (nM - fm) : WGM;
        u.pm = fm + ((wgid % nig) % gsz); u.pn = (wgid % nig) / gsz; return true;
    }
    __device__ __forceinline__ void a_ready(const Unit&) const {}
    __device__ __forceinline__ void done(const Unit&) const {}
};

struct Order {
    int nM, nN, nwg, G, c, ntf, nx, xpm0, xpn0, xnn, nsl;
    __device__ void init(int Mr, int N, int K, int G_, int c_, int nx_ = 0, int xpm0_ = 0, int xpn0_ = 0, int xnn_ = 1, int nsl_ = 1) { nM = Mr / BM; nN = N / BM; nwg = nM * nN; G = G_; c = c_; ntf = K / BK; nx = nx_; xpm0 = xpm0_; xpn0 = xpn0_; xnn = xnn_; nsl = nsl_; }
    __device__ bool next(int i, Unit& u) const {
        const long L = (long)i * G + c; if (L >= nwg + nx) return false;
        u.k0t = 0; u.ntu = ntf;
        if (L >= nwg) { const int e = (int)L - nwg, cu = e / nsl, sl = e % nsl; u.pm = xpm0 + cu / xnn; u.pn = xpn0 + cu % xnn; u.ntu = ntf / nsl; u.k0t = sl * u.ntu; return true; }
        int wgid = (int)L; { const int q = nwg / NXCD, r = nwg % NXCD, xcd = wgid % NXCD, off = wgid / NXCD; wgid = (xcd < r ? xcd * (q + 1) : r * (q + 1) + (xcd - r) * q) + off; }
        const int nig = WGM * nN, gid = wgid / nig, fm = gid * WGM, gsz = (nM - fm) < WGM ? (nM - fm) : WGM;
        u.pm = fm + ((wgid % nig) % gsz); u.pn = (wgid % nig) / gsz; return true;
    }
    __device__ __forceinline__ void a_ready(const Unit&) const {}
    __device__ __forceinline__ void done(const Unit&) const {}
};
__device__ __forceinline__ float rstd_of(float ssq) { return __builtin_amdgcn_rsqf(ssq * (1.0f / 1024.0f) + ::EPS); }
__device__ __forceinline__ int cond_of(int pm) { return pm < 64 ? (pm >> 4) : 4; }

struct EpiFFNUp {
    static constexpr bool PERM = true, AFTER_DRAIN = false;
    const float* rs; const float* sb; bf16_t* act;
    __device__ __forceinline__ void operator()(const f32x4 (&acc)[2][2][4][2], const Unit& u, int wr, int wc, int fr, int fq) const {
        const int ci = cond_of(u.pm);
        const float* sbp = sb + ci * 5632 + u.pn * 256 + wc * 32 + 8 * fq;
        const f32x4 bg0 = *(const f32x4*)(sbp), bg1 = *(const f32x4*)(sbp + 4), bu0 = *(const f32x4*)(sbp + 128), bu1 = *(const f32x4*)(sbp + 132);
        const int ocol = u.pn * 128 + wc * 32 + 8 * fq;
#pragma unroll
        for (int ai = 0; ai < 2; ++ai)
#pragma unroll
            for (int m = 0; m < 4; ++m) {
                const int row = u.pm * BM + ai * HALF + wr * 64 + m * 16 + fr;
                const float r = rstd_of(rs[row]);
                const f32x4 g0 = acc[ai][0][m][0] * r + bg0, g1 = acc[ai][0][m][1] * r + bg1, u0 = acc[ai][1][m][0] * r + bu0, u1 = acc[ai][1][m][1] * r + bu1;
                f32x4 e0 = g0 * (-1.4426950408889634f), e1 = g1 * (-1.4426950408889634f);
#pragma unroll
                for (int i = 0; i < 4; ++i) { e0[i] = __builtin_amdgcn_exp2f(e0[i]); e1[i] = __builtin_amdgcn_exp2f(e1[i]); }
                f32x4 d0 = e0 + 1.0f, d1 = e1 + 1.0f;
#pragma unroll
                for (int i = 0; i < 4; ++i) { d0[i] = __builtin_amdgcn_rcpf(d0[i]); d1[i] = __builtin_amdgcn_rcpf(d1[i]); }
                const f32x4 o0 = (g0 * u0) * d0, o1 = (g1 * u1) * d1;
                u32x4 w;
                w.x = ::pk2(o0[0], o0[1]); w.y = ::pk2(o0[2], o0[3]); w.z = ::pk2(o1[0], o1[1]); w.w = ::pk2(o1[2], o1[3]);
                *(u32x4*)(act + (size_t)row * ::FF + ocol) = w;
            }
    }
};
template <int GC2> struct EpiResid {
    static constexpr bool PERM = true, AFTER_DRAIN = false;
    const float* base_l; const float* base_c; float* out_l; float* out_c;
    const float* gate;
    const float* ng; const float* nscale;
    bf16_t* xn; float* rs_next;
    float* part;
    __device__ __forceinline__ void operator()(const f32x4 (&acc)[2][2][4][2], const Unit& u, int wr, int wc, int fr, int fq) const {
        const int ci = cond_of(u.pm); constexpr float gcoef = 0.5f * GC2;
        const bool lat = u.pm < 64;
        const bool slice = !lat && part != nullptr;
        const float* bp = lat ? base_l : base_c; float* op = slice ? part + (size_t)(u.k0t / u.ntu) * ::MC * ::D : (lat ? out_l : out_c);
        const float* ngu = slice ? nullptr : ng; float* rsu = slice ? nullptr : rs_next;
        const int rbase = lat ? u.pm * BM : (u.pm - 64) * BM;
        const int col0 = u.pn * BM + wc * 32 + 8 * fq;
        float ss[2][4];
#pragma unroll
        for (int ai = 0; ai < 2; ++ai)
#pragma unroll
            for (int m = 0; m < 4; ++m) ss[ai][m] = 0.f;
#pragma unroll
        for (int bj = 0; bj < 2; ++bj) {
            const int col = col0 + bj * HALF;
            f32x4 g0 = (f32x4){1.f, 1.f, 1.f, 1.f}, g1 = g0;
            if (!slice) { g0 = *(const f32x4*)(gate + ci * ::NMODC + col) * gcoef; g1 = *(const f32x4*)(gate + ci * ::NMODC + col + 4) * gcoef; }
            f32x4 s0 = (f32x4){0.f, 0.f, 0.f, 0.f}, s1 = s0;
            if (ngu) { s0 = *(const f32x4*)(ng + col) * (*(const f32x4*)(nscale + ci * ::NMODC + col) + 1.0f); s1 = *(const f32x4*)(ng + col + 4) * (*(const f32x4*)(nscale + ci * ::NMODC + col + 4) + 1.0f); }
#pragma unroll
            for (int ai = 0; ai < 2; ++ai)
#pragma unroll
                for (int m = 0; m < 4; ++m) {
                    const int rl = rbase + ai * HALF + wr * 64 + m * 16 + fr;
                    const int rg = u.pm * BM + ai * HALF + wr * 64 + m * 16 + fr;
                    const size_t off = (size_t)rl * ::D + col;
                    f32x4 b0 = (f32x4){0.f, 0.f, 0.f, 0.f}, b1 = b0;
                    if (!slice) { b0 = *(const f32x4*)(bp + off); b1 = *(const f32x4*)(bp + off + 4); }
                    const f32x4 x0 = b0 + g0 * acc[ai][bj][m][0], x1 = b1 + g1 * acc[ai][bj][m][1];
                    *(f32x4*)(op + off) = x0; *(f32x4*)(op + off + 4) = x1;
                    ss[ai][m] += (x0[0] * x0[0] + x0[1] * x0[1]) + (x0[2] * x0[2] + x0[3] * x0[3]) + (x1[0] * x1[0] + x1[1] * x1[1]) + (x1[2] * x1[2] + x1[3] * x1[3]);
                    if (ngu) { const f32x4 y0 = x0 * s0, y1 = x1 * s1; u32x4 w; w.x = ::pk2(y0[0], y0[1]); w.y = ::pk2(y0[2], y0[3]); w.z = ::pk2(y1[0], y1[1]); w.w = ::pk2(y1[2], y1[3]);
                        *(u32x4*)(xn + (size_t)rg * ::D + col) = w; }
                }
        }
        if (rsu) {
#pragma unroll
            for (int ai = 0; ai < 2; ++ai)
#pragma unroll
                for (int m = 0; m < 4; ++m) { float t = ss[ai][m]; t += __shfl_xor(t, 16); t += __shfl_xor(t, 32); if (fq == 0) atomicAdd(rsu + u.pm * BM + ai * HALF + wr * 64 + m * 16 + fr, t); }
        }
    }
};
struct EpiEvenIn {
    static constexpr bool PERM = false, AFTER_DRAIN = false;
    const float* rs; const float* sb; const float* rcos; const float* rsin; bf16_t* U; bf16_t* Q; bf16_t* KV;
    __device__ __forceinline__ void operator()(const f32x4 (&acc)[2][2][4][2], const Unit& u, int wr, int wc, int fr, int fq) const {
        const int ci = cond_of(u.pm); const bool lat = u.pm < 64;
        const float* sbp = sb + ci * 5632 + u.pn * 256 + wc * 32 + 4 * fq;
        f32x4 bv[2][2];
#pragma unroll
        for (int bj = 0; bj < 2; ++bj)
#pragma unroll
            for (int n = 0; n < 2; ++n) bv[bj][n] = *(const f32x4*)(sbp + bj * HALF + 16 * n);
        const int cw = wc * 32 + 4 * fq;
#pragma unroll
        for (int ai = 0; ai < 2; ++ai)
#pragma unroll
            for (int m = 0; m < 4; ++m) {
                const int row = u.pm * BM + ai * HALF + wr * 64 + m * 16 + fr;
                const float r = rstd_of(rs[row]);
                f32x4 h[2][2];
#pragma unroll
                for (int bj = 0; bj < 2; ++bj)
#pragma unroll
                    for (int n = 0; n < 2; ++n) h[bj][n] = acc[ai][bj][m][n] * r + bv[bj][n];
                if (u.pn < 4) {
#pragma unroll
                    for (int n = 0; n < 2; ++n) { const f32x4 v = h[0][n], g = h[1][n]; u32x2 w; w.x = ::pk2(v[0] * ::sigmoidf_(g[0]), v[1] * ::sigmoidf_(g[1])); w.y = ::pk2(v[2] * ::sigmoidf_(g[2]), v[3] * ::sigmoidf_(g[3]));
                        *(u32x2*)(U + (size_t)row * 512 + u.pn * 128 + cw + 16 * n) = w; }
                } else {
                    f32x4 cs = (f32x4){1.f, 1.f, 1.f, 1.f}, sn = (f32x4){0.f, 0.f, 0.f, 0.f};
                    if (lat) { const int pos = row & (::SEQ - 1); const int p = (wc & 1) ? (pos & 63) : (pos >> 6); cs = *(const f32x4*)(rcos + p * 16 + 4 * fq); sn = *(const f32x4*)(rsin + p * 16 + 4 * fq); }
                    if (u.pn < 6) {
#pragma unroll
                        for (int bj = 0; bj < 2; ++bj) { const f32x4 x1 = h[bj][0], x2 = h[bj][1]; const f32x4 o1 = (x1 * cs - x2 * sn) * ::QSCALE, o2 = (x2 * cs + x1 * sn) * ::QSCALE;
                            bf16_t* qp = Q + (size_t)row * 512 + (u.pn - 4) * 256 + bj * HALF + cw;
                            u32x2 w; w.x = ::pk2(o1[0], o1[1]); w.y = ::pk2(o1[2], o1[3]); *(u32x2*)(qp) = w; w.x = ::pk2(o2[0], o2[1]); w.y = ::pk2(o2[2], o2[3]); *(u32x2*)(qp + 16) = w; }
                    } else {
                        { const f32x4 x1 = h[0][0], x2 = h[0][1]; const f32x4 o1 = x1 * cs - x2 * sn, o2 = x2 * cs + x1 * sn; bf16_t* kp = KV + (size_t)row * 256 + cw;
                            u32x2 w; w.x = ::pk2(o1[0], o1[1]); w.y = ::pk2(o1[2], o1[3]); *(u32x2*)(kp) = w; w.x = ::pk2(o2[0], o2[1]); w.y = ::pk2(o2[2], o2[3]); *(u32x2*)(kp + 16) = w; }
                        { bf16_t* vp = KV + (size_t)row * 256 + 128 + cw;
#pragma unroll
                            for (int n = 0; n < 2; ++n) { const f32x4 v = h[1][n]; u32x2 w; w.x = ::pk2(v[0], v[1]); w.y = ::pk2(v[2], v[3]); *(u32x2*)(vp + 16 * n) = w; } }
                    }
                }
            }
    }
};
struct EpiOddIn {
    static constexpr bool PERM = true, AFTER_DRAIN = false;
    const float* rs; const float* sb; bf16_t* QKV;
    __device__ __forceinline__ void operator()(const f32x4 (&acc)[2][2][4][2], const Unit& u, int wr, int wc, int fr, int fq) const {
        const int ci = cond_of(u.pm);
        const float* sbp = sb + ci * 5632 + u.pn * 256 + wc * 32 + 8 * fq;
        const int which = u.pn >> 2; const float sc = which == 1 ? 0.0625f : 1.0f;
        bf16_t* dst = QKV + (size_t)which * ::M * ::D + (u.pn & 3) * 256 + wc * 32 + 8 * fq;
        f32x4 bv[2][2];
#pragma unroll
        for (int bj = 0; bj < 2; ++bj)
#pragma unroll
            for (int n = 0; n < 2; ++n) bv[bj][n] = *(const f32x4*)(sbp + bj * HALF + 4 * n);
#pragma unroll
        for (int ai = 0; ai < 2; ++ai)
#pragma unroll
            for (int m = 0; m < 4; ++m) {
                const int row = u.pm * BM + ai * HALF + wr * 64 + m * 16 + fr;
                const float r = rstd_of(rs[row]);
#pragma unroll
                for (int bj = 0; bj < 2; ++bj) { const f32x4 v0 = (acc[ai][bj][m][0] * r + bv[bj][0]) * sc, v1 = (acc[ai][bj][m][1] * r + bv[bj][1]) * sc;
                    u32x4 w; w.x = ::pk2(v0[0], v0[1]); w.y = ::pk2(v0[2], v0[3]); w.z = ::pk2(v1[0], v1[1]); w.w = ::pk2(v1[2], v1[3]);
                    *(u32x4*)(dst + (size_t)row * ::D + bj * HALF) = w; }
            }
    }
};
struct EpiOddGate {
    static constexpr bool PERM = true, AFTER_DRAIN = false;
    const float* rs; const float* sb; const bf16_t* HN; bf16_t* MIXA;
    __device__ __forceinline__ void operator()(const f32x4 (&acc)[2][2][4][2], const Unit& u, int wr, int wc, int fr, int fq) const {
        const int ci = cond_of(u.pm);
        const int col0 = u.pn * 256 + wc * 32 + 8 * fq;
        const float* sbp = sb + ci * 5632 + 3072 + col0;
        f32x4 bv[2][2];
#pragma unroll
        for (int bj = 0; bj < 2; ++bj)
#pragma unroll
            for (int n = 0; n < 2; ++n) bv[bj][n] = *(const f32x4*)(sbp + bj * HALF + 4 * n);
#pragma unroll
        for (int ai = 0; ai < 2; ++ai)
#pragma unroll
            for (int m = 0; m < 4; ++m) {
                const int row = u.pm * BM + ai * HALF + wr * 64 + m * 16 + fr;
                const float r = rstd_of(rs[row]);
#pragma unroll
                for (int bj = 0; bj < 2; ++bj) { const f32x4 v0 = acc[ai][bj][m][0] * r + bv[bj][0], v1 = acc[ai][bj][m][1] * r + bv[bj][1];
                    const u32x4 hn = *(const u32x4*)(HN + (size_t)row * ::D + col0 + bj * HALF);
                    u32x4 w; w.x = ::pk2(::sigmoidf_(v0[0]) * ::bflo(hn.x), ::sigmoidf_(v0[1]) * ::bfhi(hn.x)); w.y = ::pk2(::sigmoidf_(v0[2]) * ::bflo(hn.y), ::sigmoidf_(v0[3]) * ::bfhi(hn.y));
                    w.z = ::pk2(::sigmoidf_(v1[0]) * ::bflo(hn.z), ::sigmoidf_(v1[1]) * ::bfhi(hn.z)); w.w = ::pk2(::sigmoidf_(v1[2]) * ::bflo(hn.w), ::sigmoidf_(v1[3]) * ::bfhi(hn.w));
                    *(u32x4*)(MIXA + (size_t)row * ::D + col0 + bj * HALF) = w; }
            }
    }
};
template <class Epi, class Sched, bool ALIGN_EPI = false, bool SP2 = false>
__device__ __forceinline__ void gemm_phase(PG8_LAS unsigned char* lds, const Gemm g, const Sched& S, const Epi& E) {
    const int tid = ::tid_opaque(), wid = __builtin_amdgcn_readfirstlane(tid >> 6), lane = tid & 63, wr = wid >> 2, wc = wid & 3, fr = lane & 15, fq = lane >> 4;
    const int K = g.K, nt = K / BK;
    unsigned voffA[2], voffB[2];
#pragma unroll
    for (int i = 0; i < 2; ++i) { int R, C; stage_rc(tid * 16 + i * 8192, R, C); const int Rb = Epi::PERM ? ((R & ~31) + perm32(R & 31)) : R;
        voffA[i] = (unsigned)(R * K + C) * 2u; voffB[i] = (unsigned)(Rb * K + C) * 2u; }
    const size_t kstep = (size_t)(BK * 2);
    const size_t hstep = (size_t)HALF * K * 2;
    const size_t tstep = 2 * hstep;
    const unsigned ldsw = (unsigned)wid * 1024u;
    const int aoff = lds_byte(wr * 64 + fr, fq * 8), boff = lds_byte(wc * 32 + fr, fq * 8);
#define PG8_SA(b, h) (((b) * 2 + (h)) * HTB)
#define PG8_SB(b, h) ((4 + (b) * 2 + (h)) * HTB)
#define PG8_STAGE(bufoff, gbase, voff) do { _Pragma("unroll") for (int _i = 0; _i < 2; ++_i) \
        __builtin_amdgcn_global_load_lds((const unsigned*)((const char*)(gbase) + (voff)[_i]), (PG8_LAS unsigned*)(lds + (bufoff) + ldsw + _i * 8192), 16, 0, 0); } while (0)
#define PG8_LDA(dst, b, h) do { _Pragma("unroll") for (int m = 0; m < 4; ++m) _Pragma("unroll") for (int k = 0; k < 2; ++k) dst[m][k] = *(const PG8_LAS bf16x8*)(lds + PG8_SA(b, h) + aoff + m * 2048 + k * 1024); } while (0)
#define PG8_LDB(dst, b, h) do { _Pragma("unroll") for (int n = 0; n < 2; ++n) _Pragma("unroll") for (int k = 0; k < 2; ++k) dst[n][k] = *(const PG8_LAS bf16x8*)(lds + PG8_SB(b, h) + boff + n * 2048 + k * 1024); } while (0)
#define PG8_MMA(ai, bj, At, Bt) do { __builtin_amdgcn_s_setprio(1); _Pragma("unroll") for (int m = 0; m < 4; ++m) _Pragma("unroll") for (int n = 0; n < 2; ++n) _Pragma("unroll") for (int k = 0; k < 2; ++k) \
        acc[ai][bj][m][n] = __builtin_amdgcn_mfma_f32_16x16x32_bf16(Bt[n][k], At[m][k], acc[ai][bj][m][n], 0, 0, 0); __builtin_amdgcn_s_setprio(0); } while (0)
#define PG8_WAIT_V(n) asm volatile("s_waitcnt vmcnt(" #n ")" ::: "memory")
#define PG8_WAIT_L(n) asm volatile("s_waitcnt lgkmcnt(" #n ")" ::: "memory")
#define PG8_BAR __builtin_amdgcn_s_barrier()
#define PG8_SCHED __builtin_amdgcn_sched_barrier(0)
    Unit cur, nxt; int ui = 0;
    if (!S.next(0, cur)) return;
    int cnt = cur.ntu;
    f32x4 acc[2][2][4][2];
#pragma unroll
    for (int a = 0; a < 2; ++a)
#pragma unroll
        for (int b = 0; b < 2; ++b)
#pragma unroll
            for (int m = 0; m < 4; ++m)
#pragma unroll
                for (int n = 0; n < 2; ++n) acc[a][b][m][n] = (f32x4){0.f, 0.f, 0.f, 0.f};
    bf16x8 At[4][2], B0[2][2], B1[2][2];
    const char* cA = (const char*)g.A + (size_t)cur.pm * tstep + (size_t)cur.k0t * kstep; const char* cB = (const char*)g.Bt + (size_t)cur.pn * tstep + (size_t)cur.k0t * kstep;
    S.a_ready(cur);
    if constexpr (SP2) {
        PG8_STAGE(PG8_SB(0, 0), cB, voffB); PG8_STAGE(PG8_SB(0, 1), cB + hstep, voffB); PG8_STAGE(PG8_SA(0, 0), cA, voffA); PG8_STAGE(PG8_SA(0, 1), cA + hstep, voffA);
        if (wr == 1) PG8_BAR;
        PG8_WAIT_V(2); PG8_BAR;
        PG8_STAGE(PG8_SB(1, 0), cB + kstep, voffB); PG8_STAGE(PG8_SA(1, 0), cA + kstep, voffA); PG8_STAGE(PG8_SB(1, 1), cB + hstep + kstep, voffB);
        PG8_WAIT_V(6); PG8_BAR;
    } else {
        PG8_STAGE(PG8_SB(0, 0), cB, voffB); PG8_STAGE(PG8_SA(0, 0), cA, voffA); PG8_STAGE(PG8_SB(0, 1), cB + hstep, voffB); PG8_STAGE(PG8_SA(0, 1), cA + hstep, voffA);
        if (wr == 1) PG8_BAR;
        PG8_WAIT_V(4); PG8_BAR;
        PG8_STAGE(PG8_SB(1, 0), cB + kstep, voffB); PG8_STAGE(PG8_SA(1, 0), cA + kstep, voffA); PG8_STAGE(PG8_SB(1, 1), cB + hstep + kstep, voffB);
        PG8_WAIT_V(6); PG8_BAR;
    }
    for (;;) {
        const bool has_next = S.next(ui + 1, nxt);
        const char* nA = has_next ? (const char*)g.A + (size_t)nxt.pm * tstep + (size_t)nxt.k0t * kstep : cA; const char* nB = has_next ? (const char*)g.Bt + (size_t)nxt.pn * tstep + (size_t)nxt.k0t * kstep : cB;
        for (int t = 0; t < cnt; t += 2) {
            const bool last = (t == cnt - 2);
            const char* a1 = cA + (size_t)(t + 1) * kstep;
            const char* a2 = last ? nA : cA + (size_t)(t + 2) * kstep; const char* b2 = last ? nB : cB + (size_t)(t + 2) * kstep;
            const char* a3 = a2 + kstep; const char* b3 = b2 + kstep;
            if (last && has_next) S.a_ready(nxt);
            if constexpr (SP2) {
            PG8_LDB(B0, 0, 0); PG8_LDB(B1, 0, 1); PG8_SCHED; PG8_LDA(At, 0, 0); PG8_STAGE(PG8_SA(1, 1), a1 + hstep, voffA);
            PG8_WAIT_V(8); PG8_WAIT_L(0); PG8_BAR; PG8_MMA(0, 0, At, B0); PG8_MMA(0, 1, At, B1); PG8_BAR; PG8_SCHED;
            PG8_LDA(At, 0, 1); PG8_STAGE(PG8_SB(0, 0), b2, voffB); PG8_STAGE(PG8_SB(0, 1), b2 + hstep, voffB); PG8_STAGE(PG8_SA(0, 0), a2, voffA);
            PG8_WAIT_V(8); PG8_WAIT_L(0); PG8_BAR; PG8_MMA(1, 0, At, B0); PG8_MMA(1, 1, At, B1); PG8_BAR; PG8_SCHED;
            PG8_LDB(B0, 1, 0); PG8_LDB(B1, 1, 1); PG8_SCHED; PG8_LDA(At, 1, 0); PG8_STAGE(PG8_SA(0, 1), a2 + hstep, voffA);
            PG8_WAIT_V(8); PG8_WAIT_L(0); PG8_BAR; PG8_MMA(0, 0, At, B0); PG8_MMA(0, 1, At, B1); PG8_BAR; PG8_SCHED;
            PG8_LDA(At, 1, 1); PG8_STAGE(PG8_SB(1, 0), b3, voffB); PG8_STAGE(PG8_SB(1, 1), b3 + hstep, voffB); PG8_STAGE(PG8_SA(1, 0), a3, voffA);
            PG8_WAIT_V(8); PG8_WAIT_L(0); PG8_BAR; PG8_MMA(1, 0, At, B0); PG8_MMA(1, 1, At, B1); PG8_BAR; PG8_SCHED;
            } else {
            PG8_LDB(B0, 0, 0); PG8_SCHED; PG8_LDA(At, 0, 0); PG8_STAGE(PG8_SA(1, 1), a1 + hstep, voffA);
            PG8_WAIT_L(8); PG8_BAR; PG8_WAIT_L(0); PG8_MMA(0, 0, At, B0); PG8_BAR; PG8_SCHED;
            PG8_LDB(B1, 0, 1); PG8_STAGE(PG8_SB(0, 0), b2, voffB);
            PG8_BAR; PG8_WAIT_L(0); PG8_MMA(0, 1, At, B1); PG8_BAR;
            PG8_LDA(At, 0, 1); PG8_STAGE(PG8_SA(0, 0), a2, voffA);
            PG8_BAR; PG8_WAIT_L(0); PG8_MMA(1, 0, At, B0); PG8_BAR; PG8_SCHED;
            PG8_STAGE(PG8_SB(0, 1), b2 + hstep, voffB);
            PG8_WAIT_V(6); PG8_BAR; PG8_MMA(1, 1, At, B1); PG8_BAR;
            PG8_LDB(B0, 1, 0); PG8_SCHED; PG8_LDA(At, 1, 0); PG8_STAGE(PG8_SA(0, 1), a2 + hstep, voffA);
            PG8_WAIT_L(8); PG8_BAR; PG8_WAIT_L(0); PG8_MMA(0, 0, At, B0); PG8_BAR; PG8_SCHED;
            PG8_LDB(B1, 1, 1); PG8_STAGE(PG8_SB(1, 0), b3, voffB);
            PG8_BAR; PG8_WAIT_L(0); PG8_MMA(0, 1, At, B1); PG8_BAR;
            PG8_LDA(At, 1, 1); PG8_STAGE(PG8_SA(1, 0), a3, voffA);
            PG8_BAR; PG8_WAIT_L(0); PG8_MMA(1, 0, At, B0); PG8_BAR; PG8_SCHED;
            PG8_STAGE(PG8_SB(1, 1), b3 + hstep, voffB);
            PG8_WAIT_V(6); PG8_BAR; PG8_MMA(1, 1, At, B1); PG8_BAR;
            }
        }
        if constexpr (ALIGN_EPI) { if (wr == 0) PG8_BAR; }
        if constexpr (!Epi::AFTER_DRAIN) { E(acc, cur, wr, wc, fr, fq); S.done(cur); }
        if (!has_next) break;
#pragma unroll
        for (int a = 0; a < 2; ++a)
#pragma unroll
            for (int b = 0; b < 2; ++b)
#pragma unroll
                for (int m = 0; m < 4; ++m)
#pragma unroll
                    for (int n = 0; n < 2; ++n) acc[a][b][m][n] = (f32x4){0.f, 0.f, 0.f, 0.f};
        cur = nxt; cnt = cur.ntu; cA = nA; cB = nB; ++ui;
        if constexpr (ALIGN_EPI) { if (wr == 1) PG8_BAR; }
    }
    PG8_WAIT_V(0);
    if constexpr (!ALIGN_EPI) { if (wr == 0) PG8_BAR; }
    PG8_BAR;
    if constexpr (Epi::AFTER_DRAIN) { E.fused(acc, cur, wr, wc, fr, fq, lds, wid, lane); S.done(cur); }
#undef PG8_SA
#undef PG8_SB
#undef PG8_STAGE
#undef PG8_LDA
#undef PG8_LDB
#undef PG8_MMA
#undef PG8_WAIT_V
#undef PG8_WAIT_L
#undef PG8_BAR
#undef PG8_SCHED
}
}
struct Ctx {
    unsigned char* tab;
    __device__ __forceinline__ unsigned long long ldp(int i) const { const volatile unsigned* p = (const volatile unsigned*)(tab + 8 * i); unsigned lo = p[0], hi = p[1];
        lo = __builtin_amdgcn_readfirstlane(lo); hi = __builtin_amdgcn_readfirstlane(hi); return ((unsigned long long)hi << 32) | lo; }
    __device__ __forceinline__ const float* in(int i) const { return (const float*)(const __attribute__((address_space(1))) float*)ldp(i); }
    __device__ __forceinline__ float* out() const { return (float*)(__attribute__((address_space(1))) float*)ldp(25); }
    __device__ __forceinline__ unsigned char* ws() const { return (unsigned char*)(__attribute__((address_space(1))) unsigned char*)ldp(26); }
};
__device__ __forceinline__ float* ws_f(const Ctx& C, size_t off) { return (float*)(C.ws() + off); }
__device__ __forceinline__ bf16_t* ws_h(const Ctx& C, size_t off) { return (bf16_t*)(C.ws() + off); }

__device__ __forceinline__ void transpose_item(const float* W, int ldw, int K, bf16_t* WT, int k0, int n0, int drow0, float* scr, int lane) {
    float tv[32];
#pragma unroll
    for (int i = 0; i < 32; ++i) { const int kk = 2 * i + (lane >> 5); tv[i] = W[(size_t)(k0 + kk) * ldw + n0 + (lane & 31)]; }
#pragma unroll
    for (int i = 0; i < 32; ++i) { const int kk = 2 * i + (lane >> 5); scr[kk * 33 + (lane & 31)] = tv[i]; }
    __builtin_amdgcn_wave_barrier();
    const int c = lane & 7;
#pragma unroll
    for (int j = 0; j < 4; ++j) { const int n = (lane >> 3) + 8 * j; const float* s = scr + (8 * c) * 33 + n;
        u32x4 o; o.x = pk2(s[0 * 33], s[1 * 33]); o.y = pk2(s[2 * 33], s[3 * 33]); o.z = pk2(s[4 * 33], s[5 * 33]); o.w = pk2(s[6 * 33], s[7 * 33]);
        *(u32x4*)(WT + (size_t)(drow0 + n) * K + k0 + 8 * c) = o; }
    __builtin_amdgcn_wave_barrier();
}
__device__ __forceinline__ int map_gu(int n0) { return n0 < FF ? 256 * (n0 / 128) + (n0 % 128) : 256 * ((n0 - FF) / 128) + 128 + ((n0 - FF) % 128); }
__device__ __forceinline__ int map_ev(int n0) { return n0 < 512 ? 256 * (n0 / 128) + (n0 % 128) : (n0 < 1024 ? 256 * ((n0 - 512) / 128) + 128 + ((n0 - 512) % 128) : n0); }

__device__ __forceinline__ void block_transpose_item(const float* W, int ldw, int K, bf16_t* WT, int k0, int n0, int mapm, unsigned char* lds, int tid) {
    float* tile = (float*)lds;
    const int lane = tid & 63, wave = tid >> 6;
    f32x4 v[8];
#pragma unroll
    for (int rr = 0; rr < 8; ++rr) v[rr] = *(const f32x4*)(W + (size_t)(k0 + wave * 8 + rr) * ldw + n0 + 4 * lane);
    __syncthreads();
#pragma unroll
    for (int rr = 0; rr < 8; ++rr) *(f32x4*)(tile + (wave * 8 + rr) * 260 + 4 * lane) = v[rr];
    __syncthreads();
    const int n = tid & 255, half = tid >> 8; const float* tp = tile + (32 * half) * 260 + n;
    const int ng = n0 + n, n32 = ng & ~31; const int dn = (mapm == 1 ? map_gu(n32) : (mapm == 2 ? map_ev(n32) : n32)) + (ng & 31);
    bf16_t* op = WT + (size_t)dn * K + k0 + 32 * half;
#pragma unroll
    for (int q = 0; q < 4; ++q) { u32x4 o; o.x = pk2(tp[(8 * q + 0) * 260], tp[(8 * q + 1) * 260]); o.y = pk2(tp[(8 * q + 2) * 260], tp[(8 * q + 3) * 260]); o.z = pk2(tp[(8 * q + 4) * 260], tp[(8 * q + 5) * 260]); o.w = pk2(tp[(8 * q + 6) * 260], tp[(8 * q + 7) * 260]);
        *(u32x4*)(op + 8 * q) = o; }
}
constexpr int I_GU = 16 * 22, I_D = 44 * 4, I_EIN = 16 * 7, I_SQ = 16 * 4, I_OIN = 16 * 16;
__device__ __forceinline__ void conv_gu(const Ctx& C, unsigned char* wsb, int l, int f, int r, unsigned char* lds, int tid) { const int kb = r / 22, nb = r % 22;
    block_transpose_item(C.in(f ? 11 : 7) + (size_t)l * D * 2 * FF, 2 * FF, D, (bf16_t*)(wsb + WS_WGU) + (size_t)(l * 2 + f) * 5632 * D, 64 * kb, 256 * nb, 1, lds, tid); }
__device__ __forceinline__ void conv_d(const Ctx& C, unsigned char* wsb, int l, int f, int r, unsigned char* lds, int tid) { const int kb = r / 4, nb = r % 4;
    block_transpose_item(C.in(f ? 12 : 8) + (size_t)l * FF * D, D, FF, (bf16_t*)(wsb + WS_WD) + (size_t)(l * 2 + f) * D * FF, 64 * kb, 256 * nb, 0, lds, tid); }
__device__ __forceinline__ void convert_rest(const Ctx& C, unsigned char* lds, int vb, int VG) {
    const int tid = tid_opaque();
    unsigned char* wsb = C.ws();
    constexpr int NITEMS = 3 * I_GU + 3 * I_D + I_EIN + I_SQ + I_OIN + I_SQ;
    for (int it = vb; it < NITEMS; it += VG) {
        int r = it;
        if (r < 3 * I_GU) { const int mi = r / I_GU + 1; conv_gu(C, wsb, mi >> 1, mi & 1, r - (mi - 1) * I_GU, lds, tid); continue; }
        r -= 3 * I_GU;
        if (r < 3 * I_D) { const int mi = r / I_D + 1; conv_d(C, wsb, mi >> 1, mi & 1, r - (mi - 1) * I_D, lds, tid); continue; }
        r -= 3 * I_D;
        if (r < I_EIN) { const int kb = r / 7, nb = r % 7; block_transpose_item(C.in(13), EVIN, D, (bf16_t*)(wsb + WS_WEIN), 64 * kb, 256 * nb, 2, lds, tid); continue; }
        r -= I_EIN;
        if (r < I_SQ) { const int kb = r / 4, nb = r % 4; block_transpose_item(C.in(19), D, D, (bf16_t*)(wsb + WS_WEOUT), 64 * kb, 256 * nb, 0, lds, tid); continue; }
        r -= I_SQ;
        if (r < I_OIN) { const int kb = r / 16, nb = r % 16; block_transpose_item(C.in(20), ODIN, D, (bf16_t*)(wsb + WS_WOIN), 64 * kb, 256 * nb, 0, lds, tid); continue; }
        r -= I_OIN;
        { const int kb = r / 4, nb = r % 4; block_transpose_item(C.in(23), D, D, (bf16_t*)(wsb + WS_WOOUT), 64 * kb, 256 * nb, 0, lds, tid); }
    }
    __syncthreads();
}

__device__ __forceinline__ void phase_p0(const Ctx& C, unsigned char* lds, int G) {
    const int tid = tid_opaque(), lane = tid & 63, wave = tid >> 6;
    unsigned char* wsb = C.ws();
    float* sc = (float*)(lds + 81920);
    { const float* cc = C.in(1); const float* cx = C.in(3);
#pragma unroll
      for (int it = 0; it < 10; ++it) { const int i = tid + 512 * it; const int ci = i >> 10, k = i & 1023; const float v = ci < 4 ? cc[ci * D + k] : cx[k]; sc[i] = siluf_(v); } }
    __syncthreads();
    const int gw = blockIdx.x * 8 + wave, NGW = G * 8;
    float* MODS = (float*)(wsb + WS_MODS);
    const float* modw = C.in(4); const float* modb = C.in(5);
    for (int item = wave * G + (int)blockIdx.x; item < 2 * 36 * 16; item += NGW) {
        const int l = item / 576, r = item % 576, ch = r >> 4, ksl = r & 15, j0 = ch * 256 + 4 * lane, k0 = ksl * 64;
        const float* w = modw + (size_t)l * D * NMODC + (size_t)k0 * NMODC + j0;
        f32x4 a0 = {0.f, 0.f, 0.f, 0.f}, a1 = a0, a2 = a0, a3 = a0, a4 = a0;
#pragma unroll 16
        for (int kk = 0; kk < 64; ++kk) { const f32x4 wv = *(const f32x4*)(w + (size_t)kk * NMODC); const int k = k0 + kk;
            a0 += wv * sc[k]; a1 += wv * sc[D + k]; a2 += wv * sc[2 * D + k]; a3 += wv * sc[3 * D + k]; a4 += wv * sc[4 * D + k]; }
        if (ksl == 0) { const f32x4 bv = *(const f32x4*)(modb + l * NMODC + j0); a0 += bv; a1 += bv; a2 += bv; a3 += bv; a4 += bv; }
        float* mp = MODS + (size_t)(l * 5) * NMODC + j0;
#pragma unroll
        for (int e = 0; e < 4; ++e) { atomicAdd(mp + e, a0[e]); atomicAdd(mp + NMODC + e, a1[e]); atomicAdd(mp + 2 * NMODC + e, a2[e]); atomicAdd(mp + 3 * NMODC + e, a3[e]); atomicAdd(mp + 4 * NMODC + e, a4[e]); }
    }
    if (blockIdx.x == 0) { for (int i = tid; i < 1024; i += 512) { const int p = i >> 4, f = i & 15; const float inv = exp2f(-(float)f * (13.287712379549449f / 16.0f)); const float rev = (float)p * inv * 0.15915494309189535f;
            float* rp = (float*)(wsb + WS_ROPE); rp[i] = __builtin_amdgcn_cosf(rev); rp[1024 + i] = __builtin_amdgcn_sinf(rev); } }
    for (int it = blockIdx.x; it < I_GU + I_D; it += G) { if (it < I_GU) conv_gu(C, wsb, 0, 0, it, lds, tid); else conv_d(C, wsb, 0, 0, it - I_GU, lds, tid); }
    __syncthreads();
}

__device__ __forceinline__ void phase_p0b(const Ctx& C, unsigned char* lds, int G) {
    const int tid = tid_opaque(), lane = tid & 63, wave = tid >> 6;
    const int gw = blockIdx.x * 8 + wave, NGW = G * 8;
    unsigned char* wsb = C.ws();
    const float* MODS = (const float*)(wsb + WS_MODS);
    float* sh = (float*)lds;
#pragma unroll 20
    for (int it = 0; it < 60; ++it) { const int i = tid + 512 * it; const int inst = i / (5 * D), r = i % (5 * D), ci = r >> 10, kk = r & 1023; sh[i] = MODS[(size_t)((inst / 3) * 5 + ci) * NMODC + (3 * (inst % 3)) * D + kk]; }
    float* RS = (float*)(wsb + WS_RS); bf16_t* XN = (bf16_t*)(wsb + WS_XN);
    const float* xin = C.in(0); const float* cin = C.in(2); const float* g = C.in(6);
    for (int r0 = 2 * gw; r0 < M; r0 += 2 * NGW) {
        f32x4 v[2][4]; float ss[2];
#pragma unroll
        for (int q = 0; q < 2; ++q) { const int r = r0 + q; const float* xr = r < ML ? xin + (size_t)r * D : cin + (size_t)(r - ML) * D;
#pragma unroll
            for (int j = 0; j < 4; ++j) v[q][j] = *(const f32x4*)(xr + 4 * lane + 256 * j); }
#pragma unroll
        for (int q = 0; q < 2; ++q) { float t = 0.f;
#pragma unroll
            for (int j = 0; j < 4; ++j) t += (v[q][j][0] * v[q][j][0] + v[q][j][1] * v[q][j][1]) + (v[q][j][2] * v[q][j][2] + v[q][j][3] * v[q][j][3]);
            ss[q] = wave_sum(t); }
        const int ci = r0 < ML ? r0 >> 12 : 4; const float* scl = MODS + (size_t)ci * NMODC + D;
#pragma unroll
        for (int q = 0; q < 2; ++q) { const int r = r0 + q; if (lane == 0) RS[r] = ss[q];
#pragma unroll
            for (int j = 0; j < 4; ++j) { const int col = 4 * lane + 256 * j; const f32x4 y = v[q][j] * (*(const f32x4*)(g + col) * (*(const f32x4*)(scl + col) + 1.0f));
                u32x2 w; w.x = pk2(y[0], y[1]); w.y = pk2(y[2], y[3]); *(u32x2*)(XN + (size_t)r * D + col) = w; } }
    }
    __syncthreads();
    float* SB = (float*)(wsb + WS_SB);
    constexpr int C_GU = 88, C_EV = 28, C_OD = 64;
    constexpr int NCH = 4 * C_GU + C_EV + C_OD;
    for (int item = gw; item < NCH * 16; item += NGW) {
        const int ksl = item & 15; int ch = item >> 4; int inst, N, ldw, mapm; const float* W;
        if (ch < 4 * C_GU) { const int mi = ch / C_GU; ch -= mi * C_GU; const int l = mi >> 1, f = mi & 1; inst = l * 3 + 2 * f; N = 5632; ldw = 5632; mapm = 1; W = C.in(f ? 11 : 7) + (size_t)l * D * 5632; }
        else if (ch < 4 * C_GU + C_EV) { ch -= 4 * C_GU; inst = 1; N = EVIN; ldw = EVIN; mapm = 2; W = C.in(13); }
        else { ch -= 4 * C_GU + C_EV; inst = 4; N = ODN; ldw = ODIN; mapm = 0; W = C.in(20); }
        const int n = ch * 64 + lane, k0 = ksl * 64;
        const float* wp = W + (size_t)k0 * ldw + n; const float* shp = sh + inst * 5 * D + k0;
        float a0 = 0.f, a1 = 0.f, a2 = 0.f, a3 = 0.f, a4 = 0.f;
#pragma unroll 32
        for (int kk = 0; kk < 64; ++kk) { const float wv = wp[(size_t)kk * ldw]; a0 += shp[kk] * wv; a1 += shp[D + kk] * wv; a2 += shp[2 * D + kk] * wv; a3 += shp[3 * D + kk] * wv; a4 += shp[4 * D + kk] * wv; }
        const int n32 = n & ~31; const int dn = (mapm == 1 ? map_gu(n32) : (mapm == 2 ? map_ev(n32) : n32)) + (n & 31);
        float* sp = SB + (size_t)(inst * 5) * 5632 + dn;
        atomicAdd(sp, a0); atomicAdd(sp + 5632, a1); atomicAdd(sp + 2 * 5632, a2); atomicAdd(sp + 3 * 5632, a3); atomicAdd(sp + 4 * 5632, a4);
    }
    __syncthreads();
    convert_rest(C, lds, blockIdx.x, G);
}

__device__ __forceinline__ void phase_gates(const Ctx& C, unsigned char* lds, int G) {
    const int tid = tid_opaque(), lane = tid & 63, wave = tid >> 6, m16 = lane & 15, kg = lane >> 4;
    float* wgt = (float*)lds;
    { const float* wsrc = C.in(20);
#pragma unroll
      for (int it = 0; it < 32; ++it) { const int i = tid + 512 * it; const int k = i >> 4, j = i & 15; wgt[j * 1028 + k] = wsrc[(size_t)k * ODIN + ODN + j]; } }
    float* gst = (float*)(lds + 66048);
    float* sht = (float*)(lds + 66048 + 20480);
    { const float* MODS1 = ws_f(C, WS_MODS) + (size_t)5 * NMODC; const float* gp = C.in(9) + D;
#pragma unroll
      for (int it = 0; it < 10; ++it) { const int i = tid + 512 * it, ci = i >> 10, k = i & 1023; gst[i] = gp[k] * (MODS1[(size_t)ci * NMODC + 4 * D + k] + 1.0f); sht[i] = MODS1[(size_t)ci * NMODC + 3 * D + k]; } }
    __syncthreads();
    const int nskip = (G > 64 && 800 % G != 0) ? (800 % G) : 0;
    const int gw = ((int)blockIdx.x - nskip) * 8 + wave, NGW = (G - nskip) * 8;
    const float* MODS = ws_f(C, WS_MODS) + (size_t)5 * NMODC;
    const float* RS = ws_f(C, WS_RS) + (size_t)4 * M;
    float* GT = ws_f(C, WS_GATES);
    const float* xl = C.out(); const float* xc = ws_f(C, WS_XC); const float* g = C.in(9) + D; const float* bg = C.in(21);
    for (int rg = gw < 0 ? M / 16 : gw; rg < M / 16; rg += NGW) {
        const int r = rg * 16 + m16;
        const float* xr = r < ML ? xl + (size_t)r * D : xc + (size_t)(r - ML) * D;
        const int ci = r < ML ? r >> 12 : 4;
        const float rstd = __builtin_amdgcn_rsqf(RS[r] * (1.0f / 1024.0f) + EPS);
        const float* shf = sht + ci * D; const float* gsp = gst + ci * D;
        f32x4 acc = {0.f, 0.f, 0.f, 0.f};
#pragma unroll 16
        for (int k0 = 0; k0 < D; k0 += 16) { const int k = k0 + 4 * kg;
            const f32x4 hv = *(const f32x4*)(xr + k) * rstd * *(const f32x4*)(gsp + k) + *(const f32x4*)(shf + k);
            const f32x4 wv = *(const f32x4*)(wgt + m16 * 1028 + k);
            acc = __builtin_amdgcn_mfma_f32_16x16x4f32(hv[0], wv[0], acc, 0, 0, 0); acc = __builtin_amdgcn_mfma_f32_16x16x4f32(hv[1], wv[1], acc, 0, 0, 0);
            acc = __builtin_amdgcn_mfma_f32_16x16x4f32(hv[2], wv[2], acc, 0, 0, 0); acc = __builtin_amdgcn_mfma_f32_16x16x4f32(hv[3], wv[3], acc, 0, 0, 0); }
        const float bgv = bg[m16];
#pragma unroll
        for (int j = 0; j < 4; ++j) GT[(size_t)(rg * 16 + 4 * kg + j) * 16 + m16] = acc[j] + bgv;
    }
    __syncthreads();
}

template <int NSL> __device__ __forceinline__ void phase_ctx_fin(const Ctx& C, int G, float gcoef, const float* basec, size_t gate_off, const float* ng, size_t nscale_off, size_t rs_off) {
    const int tid = tid_opaque(), lane = tid & 63, wave = tid >> 6;
    const int gw = blockIdx.x * 8 + wave, NGW = G * 8;
    unsigned char* wsb = C.ws();
    const float* part = (const float*)(wsb + WS_PART); float* XCp = (float*)(wsb + WS_XC); bf16_t* XNp = (bf16_t*)(wsb + WS_XN); float* RSp = (float*)(wsb + rs_off);
    const float* gate = (const float*)(wsb + gate_off) + 4 * NMODC; const float* nsc = (const float*)(wsb + nscale_off) + 4 * NMODC;
    for (int r = gw; r < MC; r += NGW) {
        float ss = 0.f;
#pragma unroll
        for (int j = 0; j < 4; ++j) { const int col = 4 * lane + 256 * j; f32x4 a = {0.f, 0.f, 0.f, 0.f};
#pragma unroll
            for (int sl = 0; sl < NSL; ++sl) a += *(const f32x4*)(part + ((size_t)sl * MC + r) * D + col);
            const f32x4 x = *(const f32x4*)(basec + (size_t)r * D + col) + *(const f32x4*)(gate + col) * gcoef * a; *(f32x4*)(XCp + (size_t)r * D + col) = x;
            ss += (x[0] * x[0] + x[1] * x[1]) + (x[2] * x[2] + x[3] * x[3]);
            const f32x4 y = x * (*(const f32x4*)(ng + col) * (*(const f32x4*)(nsc + col) + 1.0f));
            u32x2 w; w.x = pk2(y[0], y[1]); w.y = pk2(y[2], y[3]); *(u32x2*)(XNp + (size_t)(ML + r) * D + col) = w; }
        ss = wave_sum(ss);
        if (lane == 0) RSp[ML + r] = ss;
    }
}
__device__ __forceinline__ void phase_hn(const Ctx& C, int G) {
    const int tid = tid_opaque(), lane = tid & 63, wave = tid >> 6;
    const int gw = blockIdx.x * 8 + wave, NGW = G * 8;
    const bf16_t* HF = ws_h(C, WS_HF); const bf16_t* HB = ws_h(C, WS_HB); bf16_t* HN = ws_h(C, WS_HN); const float* ngp = C.in(22);
    for (int r0 = 2 * gw; r0 < ML; r0 += 2 * NGW) {
        u32x2 a[2][4], b[2][4];
#pragma unroll
        for (int q = 0; q < 2; ++q)
#pragma unroll
            for (int hd = 0; hd < 4; ++hd) { const size_t o = (size_t)(r0 + q) * D + hd * 256 + 4 * lane; a[q][hd] = *(const u32x2*)(HF + o); b[q][hd] = *(const u32x2*)(HB + o); }
#pragma unroll
        for (int q = 0; q < 2; ++q)
#pragma unroll
            for (int hd = 0; hd < 4; ++hd) { const int col = hd * 256 + 4 * lane;
                f32x4 s = {bflo(a[q][hd].x) + bflo(b[q][hd].x), bfhi(a[q][hd].x) + bfhi(b[q][hd].x), bflo(a[q][hd].y) + bflo(b[q][hd].y), bfhi(a[q][hd].y) + bfhi(b[q][hd].y)};
                const float ss = wave_sum((s[0] * s[0] + s[1] * s[1]) + (s[2] * s[2] + s[3] * s[3]));
                const float rr = __builtin_amdgcn_rsqf(ss * (1.0f / 256.0f) + EPS);
                const f32x4 y = s * rr * *(const f32x4*)(ngp + col);
                u32x2 w; w.x = pk2(y[0], y[1]); w.y = pk2(y[2], y[3]); *(u32x2*)(HN + (size_t)(r0 + q) * D + col) = w; }
    }
}
__device__ __forceinline__ void phase_final(const Ctx& C, int G) {
    const int tid = tid_opaque(), lane = tid & 63, wave = tid >> 6;
    const int gw = blockIdx.x * 8 + wave, NGW = G * 8;
    const float* RS = ws_f(C, WS_RS) + (size_t)6 * M; float* xo = C.out(); const float* fn = C.in(24);
    for (int r0 = 2 * gw; r0 < ML; r0 += 2 * NGW) {
        f32x4 v[2][4]; float rstd[2];
#pragma unroll
        for (int q = 0; q < 2; ++q) { rstd[q] = __builtin_amdgcn_rsqf(RS[r0 + q] * (1.0f / 1024.0f) + EPS);
#pragma unroll
            for (int j = 0; j < 4; ++j) v[q][j] = *(const f32x4*)(xo + (size_t)(r0 + q) * D + 4 * lane + 256 * j); }
#pragma unroll
        for (int q = 0; q < 2; ++q)
#pragma unroll
            for (int j = 0; j < 4; ++j) { const int col = 4 * lane + 256 * j; *(f32x4*)(xo + (size_t)(r0 + q) * D + col) = v[q][j] * rstd[q] * *(const f32x4*)(fn + col); }
    }
}
__device__ __forceinline__ bf16x8 ld_bf16x8(const void* p) { return *(const bf16x8*)p; }
__device__ __forceinline__ void attn_unit(const Ctx& C, unsigned char* lds, int qrow0, int kvh, int hp, int nch, int kr0, int kr1, int kr2, int kr3, int kr4, int md0, int md1, int md2) {
    const int tid = tid_opaque(), lane = tid & 63, wave = tid >> 6, fr = lane & 15, fq = lane >> 4;
    const bf16_t* Q = ws_h(C, WS_Q); const bf16_t* KV = ws_h(C, WS_KV); bf16_t* MIXA = ws_h(C, WS_MIXA_E);
    unsigned char* Ks = lds;
    unsigned char* Vt = lds + 18432;
    const int g = wave >> 2, quarter = wave & 3, head = kvh * 4 + hp * 2 + g;
    bf16x8 qf[2][2];
#pragma unroll
    for (int qt = 0; qt < 2; ++qt)
#pragma unroll
        for (int ks = 0; ks < 2; ++ks) qf[qt][ks] = ld_bf16x8(Q + (size_t)(qrow0 + quarter * 32 + 16 * qt + fr) * 512 + head * 64 + 32 * ks + 8 * fq);
    const float sink2 = C.in(18)[head] * LOG2E;
    float mrun[2], lrun[2]; f32x4 O[2][4];
#pragma unroll
    for (int qt = 0; qt < 2; ++qt) { mrun[qt] = sink2; lrun[qt] = 1.f;
#pragma unroll
        for (int dt = 0; dt < 4; ++dt) O[qt][dt] = (f32x4){0.f, 0.f, 0.f, 0.f}; }
    u32x4 kreg[2], vreg[2];
#define ATT_FETCH(krow_) do { _Pragma("unroll") for (int i = 0; i < 2; ++i) { const int p = tid + 512 * i; \
            kreg[i] = *(const u32x4*)(KV + (size_t)((krow_) + (p >> 3)) * 256 + kvh * 64 + 8 * (p & 7)); \
            vreg[i] = *(const u32x4*)(KV + (size_t)((krow_) + (p & 127)) * 256 + 128 + kvh * 64 + 8 * (p >> 7)); } } while (0)
    ATT_FETCH(kr0);
    for (int c = 0; c < nch; ++c) {
        const int mode = c == 0 ? md0 : (c == 1 ? md1 : (c == 2 ? md2 : 0));
        __syncthreads();
#pragma unroll
        for (int i = 0; i < 2; ++i) { const int p = tid + 512 * i;
            *(u32x4*)(Ks + (p >> 3) * 144 + (p & 7) * 16) = kreg[i];
            const u32x4 vv = vreg[i];
            bf16_t* vt = (bf16_t*)(Vt + (8 * (p >> 7)) * 272) + (p & 127);
            vt[0 * 136] = (bf16_t)(vv.x & 0xffff); vt[1 * 136] = (bf16_t)(vv.x >> 16); vt[2 * 136] = (bf16_t)(vv.y & 0xffff); vt[3 * 136] = (bf16_t)(vv.y >> 16);
            vt[4 * 136] = (bf16_t)(vv.z & 0xffff); vt[5 * 136] = (bf16_t)(vv.z >> 16); vt[6 * 136] = (bf16_t)(vv.w & 0xffff); vt[7 * 136] = (bf16_t)(vv.w >> 16); }
        __syncthreads();
        if (c + 1 < nch) { const int krn = c == 0 ? kr1 : (c == 1 ? kr2 : (c == 2 ? kr3 : kr4)); ATT_FETCH(krn); }
        const int mlo = mode == 1 ? 0 : -1000, mhi = mode == 2 ? 0 : 1000;
#pragma unroll
        for (int qt = 0; qt < 2; ++qt) {
            f32x4 st[8];
#pragma unroll
            for (int kt = 0; kt < 8; ++kt) { st[kt] = (f32x4){0.f, 0.f, 0.f, 0.f};
#pragma unroll
                for (int ks = 0; ks < 2; ++ks) st[kt] = __builtin_amdgcn_mfma_f32_16x16x32_bf16(ld_bf16x8(Ks + (16 * kt + fr) * 144 + (32 * ks + 8 * fq) * 2), qf[qt][ks], st[kt], 0, 0, 0); }
            const int qoff = quarter * 32 + 16 * qt + fr;
            float mx = -INFINITY;
#pragma unroll
            for (int kt = 0; kt < 8; ++kt)
#pragma unroll
                for (int j = 0; j < 4; ++j) { const int rel = 16 * kt + 4 * fq + j - qoff;
                    st[kt][j] = (rel < mlo || rel > mhi) ? -INFINITY : st[kt][j];
                    mx = fmaxf(mx, st[kt][j]); }
            mx = fmaxf(mx, __shfl_xor(mx, 16)); mx = fmaxf(mx, __shfl_xor(mx, 32));
            const float mnew = fmaxf(mrun[qt], mx), alpha = exp2f(mrun[qt] - mnew);
            float rsum = 0.f;
#pragma unroll
            for (int kt = 0; kt < 8; ++kt)
#pragma unroll
                for (int j = 0; j < 4; ++j) { st[kt][j] = exp2f(st[kt][j] - mnew); rsum += st[kt][j]; }
            rsum += __shfl_xor(rsum, 16); rsum += __shfl_xor(rsum, 32);
            lrun[qt] = lrun[qt] * alpha + rsum; mrun[qt] = mnew;
#pragma unroll
            for (int dt = 0; dt < 4; ++dt) O[qt][dt] *= alpha;
#pragma unroll
            for (int kk = 0; kk < 4; ++kk) {
                u32x4 pw; pw.x = pk2(st[2 * kk][0], st[2 * kk][1]); pw.y = pk2(st[2 * kk][2], st[2 * kk][3]); pw.z = pk2(st[2 * kk + 1][0], st[2 * kk + 1][1]); pw.w = pk2(st[2 * kk + 1][2], st[2 * kk + 1][3]);
                const bf16x8 pb = __builtin_bit_cast(bf16x8, pw);
#pragma unroll
                for (int dt = 0; dt < 4; ++dt) {
                    const unsigned char* vp = Vt + (16 * dt + fr) * 272 + (32 * kk + 4 * fq) * 2;
                    const u32x2 lo = *(const u32x2*)vp, hi = *(const u32x2*)(vp + 32);
                    u32x4 vw; vw.x = lo.x; vw.y = lo.y; vw.z = hi.x; vw.w = hi.y;
                    O[qt][dt] = __builtin_amdgcn_mfma_f32_16x16x32_bf16(__builtin_bit_cast(bf16x8, vw), pb, O[qt][dt], 0, 0, 0);
                }
            }
            asm volatile("" ::: "memory"); __builtin_amdgcn_sched_barrier(0);
        }
    }
#pragma unroll
    for (int qt = 0; qt < 2; ++qt) { const float inv = 1.0f / lrun[qt]; const int row = qrow0 + quarter * 32 + 16 * qt + fr;
#pragma unroll
        for (int dt = 0; dt < 4; ++dt) { const f32x4 o = O[qt][dt] * inv; u32x2 w; w.x = pk2(o[0], o[1]); w.y = pk2(o[2], o[3]);
            *(u32x2*)(MIXA + (size_t)row * D + 512 + head * 64 + 16 * dt + 4 * fq) = w; } }
#undef ATT_FETCH
}

__device__ __forceinline__ void conv_unit(const Ctx& C, unsigned char* lds, int srow0, int slen, int t0) {
    const int tid = tid_opaque(), lane = tid & 63, wave = tid >> 6, c = tid;
    unsigned char* wsb = C.ws();
    const bf16_t* U = (const bf16_t*)(wsb + WS_U); bf16_t* MIXA = (bf16_t*)(wsb + WS_MIXA_E);
    float* yt = (float*)lds;
    const int cp = tid & 255, hp = tid >> 8;
    f32x2 w2[31];
    { const float* cw = C.in(14);
#pragma unroll
      for (int j = 0; j < 31; ++j) w2[j] = *(const f32x2*)(cw + j * 512 + 2 * cp); }
    const f32x2 bias2 = *(const f32x2*)(C.in(15) + 2 * cp);
    f32x2 win[32];
#pragma unroll
    for (int i = 0; i < 32; ++i) win[i] = (f32x2){0.f, 0.f};
#pragma unroll 1
    for (int blk = 0; blk < 2; ++blk) {
        unsigned nw[32];
#pragma unroll
        for (int i = 0; i < 32; ++i) { const int il = 32 * blk + i, t = t0 - 15 + 32 * hp + il; nw[i] = (il < 62 && t >= 0 && t < slen) ? *(const unsigned*)(U + (size_t)(srow0 + t) * 512 + 2 * cp) : 0u; }
#pragma unroll
        for (int i = 0; i < 32; ++i) { win[i] = (f32x2){bflo(nw[i]), bfhi(nw[i])}; const int ol = 32 * blk + i - 30;
            if (ol >= 0 && ol < 32) { f32x2 a2 = bias2;
#pragma unroll
                for (int j = 0; j < 31; ++j) a2 += w2[j] * win[(i + 2 + j) & 31];
                *(f32x2*)(yt + (32 * hp + ol) * 512 + 2 * cp) = a2; } }
    }
    __syncthreads();
    { const float* lgp = C.in(16); const float* lbp = C.in(17);
      const f32x4 g0 = *(const f32x4*)(lgp + 4 * lane), g1 = *(const f32x4*)(lgp + 256 + 4 * lane), b0 = *(const f32x4*)(lbp + 4 * lane), b1 = *(const f32x4*)(lbp + 256 + 4 * lane);
#pragma unroll 2
      for (int r = 0; r < 8; ++r) { const int o = wave * 8 + r;
          const f32x4 y0 = *(const f32x4*)(yt + o * 512 + 4 * lane), y1 = *(const f32x4*)(yt + o * 512 + 256 + 4 * lane);
          const float s1 = wave_sum((y0[0] + y0[1]) + (y0[2] + y0[3]) + (y1[0] + y1[1]) + (y1[2] + y1[3]));
          const float mu = s1 * (1.0f / 512.0f); const f32x4 d0 = y0 - mu, d1 = y1 - mu;
          const float s2 = wave_sum((d0[0] * d0[0] + d0[1] * d0[1]) + (d0[2] * d0[2] + d0[3] * d0[3]) + (d1[0] * d1[0] + d1[1] * d1[1]) + (d1[2] * d1[2] + d1[3] * d1[3]));
          const float rstd = __builtin_amdgcn_rsqf(s2 * (1.0f / 512.0f) + EPS);
          const f32x4 v0 = d0 * rstd * g0 + b0, v1 = d1 * rstd * g1 + b1;
          bf16_t* op = MIXA + (size_t)(srow0 + t0 + o) * D;
          u32x2 wv; wv.x = pk2(siluf_(v0[0]), siluf_(v0[1])); wv.y = pk2(siluf_(v0[2]), siluf_(v0[3])); *(u32x2*)(op + 4 * lane) = wv;
          wv.x = pk2(siluf_(v1[0]), siluf_(v1[1])); wv.y = pk2(siluf_(v1[2]), siluf_(v1[3])); *(u32x2*)(op + 256 + 4 * lane) = wv; } }
}

__device__ __forceinline__ void phase_even_mix(const Ctx& C, unsigned char* lds, int G) {
    unsigned* qctr = (unsigned*)(C.ws() + WS_QCTR);
    volatile unsigned* qslot = (volatile unsigned*)(lds + LDS_BYTES - 384);
    for (;;) {
        __syncthreads();
        if (threadIdx.x == 0) *qslot = atomicAdd(qctr, 1u);
        __syncthreads();
        const int u = (int)*qslot;
        if (u >= 816) break;
        if (u < 544) {
            int qrow0, kvh, hp, nch, kr0, kr1, kr2 = 0, kr3 = 0, kr4 = 0, md0 = 0, md1 = 0, md2 = 0;
            if (u < 512) { const int b = u >> 7, qb = (u >> 2) & 31; kvh = (u >> 1) & 1; hp = u & 1; const int base = b * SEQ, c0 = ML + b * CTXL; qrow0 = base + qb * 128;
                if (qb == 0) { nch = 4; kr0 = base; kr1 = base + 128; kr2 = c0; kr3 = c0 + 128; md1 = 2; }
                else if (qb == 31) { nch = 4; kr0 = base + 30 * 128; kr1 = base + 31 * 128; kr2 = c0; kr3 = c0 + 128; md0 = 1; }
                else { nch = 5; kr0 = base + (qb - 1) * 128; kr1 = base + qb * 128; kr2 = base + (qb + 1) * 128; kr3 = c0; kr4 = c0 + 128; md0 = 1; md2 = 2; }
            } else { const int e = u - 512, b = e >> 3, hf = (e >> 1) & 1; kvh = (e >> 2) & 1; hp = e & 1; const int c0 = ML + b * CTXL; qrow0 = c0 + hf * 128; nch = 2; kr0 = c0; kr1 = c0 + 128; }
            attn_unit(C, lds, qrow0, kvh, hp, nch, kr0, kr1, kr2, kr3, kr4, md0, md1, md2);
        } else { const int e = u - 544; int s0, sl, t0;
            if (e < 256) { s0 = (e >> 6) * SEQ; sl = SEQ; t0 = (e & 63) * 64; } else { const int f = e - 256; s0 = ML + (f >> 2) * CTXL; sl = CTXL; t0 = (f & 3) * 64; }
            conv_unit(C, lds, s0, sl, t0);
            __syncthreads();
        }
    }
}
typedef short v4i16_t __attribute__((ext_vector_type(4)));
__device__ __forceinline__ s16x4 lds_tr16(const unsigned char* p) { return __builtin_bit_cast(s16x4, __builtin_amdgcn_ds_read_tr16_b64_v4i16((__attribute__((address_space(3))) v4i16_t*)p)); }
__device__ __forceinline__ void phase_scan(const Ctx& C, unsigned char* lds, int G) {
    const int tid = tid_opaque(), lane = tid & 63, wave = tid >> 6, fr = lane & 15, fq = lane >> 4;
    unsigned char* wsb = C.ws();
    const bf16_t* QB = (const bf16_t*)(wsb + WS_QKV); const bf16_t* KB = QB + (size_t)M * D; const bf16_t* VB = QB + (size_t)2 * M * D;
    const float* GT = (const float*)(wsb + WS_GATES);
    unsigned char* KT = lds;
    unsigned char* VT = lds + 69632;
    unsigned char* VW = lds + 78336;
    unsigned char* CB = lds + 91392;
    float* SC = (float*)(lds + 116736);
    const int qt = wave < 4 ? wave : 11 - wave;
    for (int unit = blockIdx.x; unit < 256; unit += G) {
        const int b = unit >> 6, h = (unit >> 4) & 3, dir = (unit >> 3) & 1, vs = unit & 7;
        bf16_t* HO = (bf16_t*)(wsb + (dir ? WS_HB : WS_HF));
        __syncthreads();
        for (int i = tid; i < (13056 + 25344) / 4; i += 512) ((unsigned*)VW)[i] = 0u;
        f32x4 Cacc[3][2];
#pragma unroll
        for (int a = 0; a < 3; ++a)
#pragma unroll
            for (int bb = 0; bb < 2; ++bb) Cacc[a][bb] = (f32x4){0.f, 0.f, 0.f, 0.f};
        float mstate = 0.f;
        u32x4 kreg[8]; u32x4 vreg; bf16x8 qn[8];
        float gi0 = 0.f, gf0 = 0.f, gi1 = 0.f, gf1 = 0.f;
#define STEP_R0(s) ((s) < 2 ? ML + b * CTXL + (dir ? 1 - (s) : (s)) * 128 : b * SEQ + (dir ? 33 - (s) : (s) - 2) * 128)
#define SROWX(r0_, l) ((r0_) + (dir ? 127 - (l) : (l)))
#define SCAN_FETCH(s) do { const int r0f = STEP_R0(s); \
            _Pragma("unroll") for (int i = 0; i < 8; ++i) { const int p = tid + 512 * i, l = p >> 5, c16 = p & 31; kreg[i] = *(const u32x4*)(KB + (size_t)SROWX(r0f, l) * D + h * 256 + 8 * c16); } \
            { const int l = tid & 127, c = tid >> 7; vreg = *(const u32x4*)(VB + (size_t)SROWX(r0f, l) * D + h * 256 + vs * 32 + 8 * c); } \
            if (wave == 0) { const int l0 = 2 * lane, l1 = l0 + 1; const float* g0p = GT + (size_t)SROWX(r0f, l0) * 16 + dir * 8 + h; const float* g1p = GT + (size_t)SROWX(r0f, l1) * 16 + dir * 8 + h; \
                gi0 = g0p[0]; gf0 = g0p[4]; gi1 = g1p[0]; gf1 = g1p[4]; } } while (0)
#define SCAN_FETCHQ(s) do { if ((s) >= 2) { const int r0f = STEP_R0(s); _Pragma("unroll") for (int ks = 0; ks < 8; ++ks) qn[ks] = ld_bf16x8(QB + (size_t)SROWX(r0f, 16 * qt + fr) * D + h * 256 + 32 * ks + 8 * fq); } } while (0)
#define SCAN_SCALARS(dst) do { float* scw = (dst); const int l0 = 2 * lane, l1 = l0 + 1; \
            const float lf0 = fminf(gf0, 0.f) - __logf(1.f + __expf(-fabsf(gf0))), lf1 = fminf(gf1, 0.f) - __logf(1.f + __expf(-fabsf(gf1))); \
            float S = lf0 + lf1; \
            _Pragma("unroll") for (int o = 1; o < 64; o <<= 1) { const float t_ = __shfl_up(S, o); if (lane >= o) S += t_; } \
            const float b1 = S, b0 = S - lf1, a0 = gi0 - b0, a1 = gi1 - b1; \
            float P = fmaxf(a0, a1); \
            _Pragma("unroll") for (int o = 1; o < 64; o <<= 1) { const float t_ = __shfl_up(P, o); if (lane >= o) P = fmaxf(P, t_); } \
            float ex = __shfl_up(P, 1); if (lane == 0) ex = -INFINITY; \
            const float pm0 = fmaxf(ex, a0), pm1 = P, PM = __shfl(P, 63), bend = __shfl(S, 63), mx = fmaxf(mstate, PM); \
            scw[l0] = a0; scw[l1] = a1; scw[128 + l0] = fmaxf(pm0, mstate); scw[128 + l1] = fmaxf(pm1, mstate); scw[256 + l0] = b0; scw[256 + l1] = b1; \
            scw[384 + l0] = __expf(a0 - mx); scw[384 + l1] = __expf(a1 - mx); \
            if (lane == 0) { scw[512] = __expf(mstate - mx); scw[513] = mstate; } \
            mstate = bend + mx; } while (0)
#pragma unroll
        for (int ks = 0; ks < 8; ++ks) qn[ks] = (bf16x8){0, 0, 0, 0, 0, 0, 0, 0};
        SCAN_FETCH(0); SCAN_FETCHQ(0);
        if (wave == 0) SCAN_SCALARS(SC);
        __syncthreads();
#pragma unroll 1
        for (int step = 0; step < 34; ++step) {
            const float* sc = SC + (step & 1) * 576;
            const int r0 = STEP_R0(step);
#pragma unroll
            for (int i = 0; i < 8; ++i) { const int p = tid + 512 * i, l = p >> 5, c16 = p & 31; *(u32x4*)(KT + l * 528 + c16 * 16) = kreg[i]; }
            { const int l = tid & 127, c = tid >> 7; const float we = sc[384 + l];
                bf16_t* vt = (bf16_t*)(VT + (8 * c) * 272) + l; bf16_t* vw = (bf16_t*)(VW + (8 * c) * 272) + l;
                vt[0 * 136] = (bf16_t)(vreg.x & 0xffff); vt[1 * 136] = (bf16_t)(vreg.x >> 16); vt[2 * 136] = (bf16_t)(vreg.y & 0xffff); vt[3 * 136] = (bf16_t)(vreg.y >> 16);
                vt[4 * 136] = (bf16_t)(vreg.z & 0xffff); vt[5 * 136] = (bf16_t)(vreg.z >> 16); vt[6 * 136] = (bf16_t)(vreg.w & 0xffff); vt[7 * 136] = (bf16_t)(vreg.w >> 16);
                const unsigned w0 = pk2(bflo(vreg.x) * we, bfhi(vreg.x) * we), w1 = pk2(bflo(vreg.y) * we, bfhi(vreg.y) * we), w2 = pk2(bflo(vreg.z) * we, bfhi(vreg.z) * we), w3 = pk2(bflo(vreg.w) * we, bfhi(vreg.w) * we);
                vw[0 * 136] = (bf16_t)(w0 & 0xffff); vw[1 * 136] = (bf16_t)(w0 >> 16); vw[2 * 136] = (bf16_t)(w1 & 0xffff); vw[3 * 136] = (bf16_t)(w1 >> 16);
                vw[4 * 136] = (bf16_t)(w2 & 0xffff); vw[5 * 136] = (bf16_t)(w2 >> 16); vw[6 * 136] = (bf16_t)(w3 & 0xffff); vw[7 * 136] = (bf16_t)(w3 >> 16);
                if (c == 0) ((bf16_t*)(VW + 32 * 272))[l] = (bf16_t)(pk2(we, 0.f) & 0xffff); }
            __syncthreads();
            if (step >= 2) {
                f32x4 st[8];
#pragma unroll
                for (int kt = 0; kt < 8; ++kt) st[kt] = (f32x4){0.f, 0.f, 0.f, 0.f};
#define ST_BLOCK(kt) if ((kt) <= qt) { const unsigned char* kb_ = KT + (16 * (kt) + fr) * 528 + 16 * fq; \
                    const bf16x8 k0_ = ld_bf16x8(kb_), k1_ = ld_bf16x8(kb_ + 64), k2_ = ld_bf16x8(kb_ + 128), k3_ = ld_bf16x8(kb_ + 192), k4_ = ld_bf16x8(kb_ + 256), k5_ = ld_bf16x8(kb_ + 320), k6_ = ld_bf16x8(kb_ + 384), k7_ = ld_bf16x8(kb_ + 448); \
                    f32x4 s_ = st[kt]; \
                    s_ = __builtin_amdgcn_mfma_f32_16x16x32_bf16(k0_, qn[0], s_, 0, 0, 0); s_ = __builtin_amdgcn_mfma_f32_16x16x32_bf16(k1_, qn[1], s_, 0, 0, 0); \
                    s_ = __builtin_amdgcn_mfma_f32_16x16x32_bf16(k2_, qn[2], s_, 0, 0, 0); s_ = __builtin_amdgcn_mfma_f32_16x16x32_bf16(k3_, qn[3], s_, 0, 0, 0); \
                    s_ = __builtin_amdgcn_mfma_f32_16x16x32_bf16(k4_, qn[4], s_, 0, 0, 0); s_ = __builtin_amdgcn_mfma_f32_16x16x32_bf16(k5_, qn[5], s_, 0, 0, 0); \
                    s_ = __builtin_amdgcn_mfma_f32_16x16x32_bf16(k6_, qn[6], s_, 0, 0, 0); s_ = __builtin_amdgcn_mfma_f32_16x16x32_bf16(k7_, qn[7], s_, 0, 0, 0); st[kt] = s_; }
                ST_BLOCK(0) ST_BLOCK(1) ST_BLOCK(2) ST_BLOCK(3) ST_BLOCK(4) ST_BLOCK(5) ST_BLOCK(6) ST_BLOCK(7)
#undef ST_BLOCK
                const int q = 16 * qt + fr; const float Mqq = sc[128 + q];
                float dsum = 0.f;
#pragma unroll
                for (int kt = 0; kt < 8; ++kt) { if (kt <= qt) { const f32x4 av = *(const f32x4*)(sc + 16 * kt + 4 * fq);
#pragma unroll
                        for (int j = 0; j < 4; ++j) { const int key = 16 * kt + 4 * fq + j; const float wgt = key <= q ? __expf(av[j] - Mqq) : 0.f; st[kt][j] *= wgt; dsum += st[kt][j]; } } }
                dsum += __shfl_xor(dsum, 16); dsum += __shfl_xor(dsum, 32);
                f32x4 o1[2], cq[3];
#pragma unroll
                for (int vt = 0; vt < 2; ++vt) o1[vt] = (f32x4){0.f, 0.f, 0.f, 0.f};
#pragma unroll
                for (int vt = 0; vt < 3; ++vt) cq[vt] = (f32x4){0.f, 0.f, 0.f, 0.f};
#pragma unroll
                for (int kk = 0; kk < 4; ++kk) { if (2 * kk <= qt) {
                        u32x4 pw; pw.x = pk2(st[2 * kk][0], st[2 * kk][1]); pw.y = pk2(st[2 * kk][2], st[2 * kk][3]); pw.z = pk2(st[2 * kk + 1][0], st[2 * kk + 1][1]); pw.w = pk2(st[2 * kk + 1][2], st[2 * kk + 1][3]);
                        const bf16x8 pb = __builtin_bit_cast(bf16x8, pw);
#pragma unroll
                        for (int vt = 0; vt < 2; ++vt) { const unsigned char* vp = VT + (16 * vt + fr) * 272 + (32 * kk + 4 * fq) * 2;
                            const u32x2 lo = *(const u32x2*)vp, hi = *(const u32x2*)(vp + 32); u32x4 vw; vw.x = lo.x; vw.y = lo.y; vw.z = hi.x; vw.w = hi.y;
                            o1[vt] = __builtin_amdgcn_mfma_f32_16x16x32_bf16(__builtin_bit_cast(bf16x8, vw), pb, o1[vt], 0, 0, 0); } } }
#pragma unroll
                for (int kh = 0; kh < 2; ++kh) { bf16x8 cf[4][3];
#pragma unroll
                    for (int k4 = 0; k4 < 4; ++k4)
#pragma unroll
                        for (int vt = 0; vt < 3; ++vt) cf[k4][vt] = ld_bf16x8(CB + (16 * vt + fr) * 528 + (32 * (4 * kh + k4) + 8 * fq) * 2);
#pragma unroll
                    for (int k4 = 0; k4 < 4; ++k4)
#pragma unroll
                        for (int vt = 0; vt < 3; ++vt) cq[vt] = __builtin_amdgcn_mfma_f32_16x16x32_bf16(cf[k4][vt], qn[4 * kh + k4], cq[vt], 0, 0, 0); }
                const float nq = __shfl(cq[2][0], fr);
                const float winter = __expf(sc[513] - Mqq);
                const float den = dsum + winter * nq, flo = __expf(-sc[256 + q] - Mqq);
                const float inv = 1.0f / fmaxf(fabsf(den), flo);
                bf16_t* hp = HO + (size_t)SROWX(r0, q) * D + h * 256 + vs * 32 + 4 * fq;
#pragma unroll
                for (int vt = 0; vt < 2; ++vt) { const f32x4 hv = (o1[vt] + cq[vt] * winter) * inv; u32x2 w; w.x = pk2(hv[0], hv[1]); w.y = pk2(hv[2], hv[3]); *(u32x2*)(hp + 16 * vt) = w; }
            }
            if (step + 1 < 34) { SCAN_FETCH(step + 1); SCAN_FETCHQ(step + 1); }
            if (wave == 0 && step + 1 < 34) SCAN_SCALARS(SC + ((step + 1) & 1) * 576);
            { const float decay = sc[512];
#pragma unroll
                for (int a = 0; a < 3; ++a)
#pragma unroll
                    for (int bb = 0; bb < 2; ++bb) Cacc[a][bb] *= decay;
                const int qp = (lane & 15) >> 2, pp = lane & 3;
#pragma unroll
                for (int lh = 0; lh < 2; ++lh) {
                    bf16x8 av[2][3], bw[2][2];
#pragma unroll
                    for (int l2 = 0; l2 < 2; ++l2) { const int ls = 2 * lh + l2;
#pragma unroll
                        for (int vt = 0; vt < 3; ++vt) av[l2][vt] = ld_bf16x8(VW + (16 * vt + fr) * 272 + (32 * ls + 8 * fq) * 2);
#pragma unroll
                        for (int kdt = 0; kdt < 2; ++kdt) { const unsigned char* tp = KT + (32 * ls + 8 * fq + qp) * 528 + (16 * (2 * wave + kdt) + 4 * pp) * 2;
                            const s16x4 t0 = lds_tr16(tp), t1 = lds_tr16(tp + 4 * 528);
                            bw[l2][kdt] = (bf16x8){t0[0], t0[1], t0[2], t0[3], t1[0], t1[1], t1[2], t1[3]}; } }
#pragma unroll
                    for (int l2 = 0; l2 < 2; ++l2)
#pragma unroll
                        for (int vt = 0; vt < 3; ++vt)
#pragma unroll
                            for (int kdt = 0; kdt < 2; ++kdt) Cacc[vt][kdt] = __builtin_amdgcn_mfma_f32_16x16x32_bf16(av[l2][vt], bw[l2][kdt], Cacc[vt][kdt], 0, 0, 0);
                } }
            __syncthreads();
#pragma unroll
            for (int vt = 0; vt < 3; ++vt)
#pragma unroll
                for (int kdt = 0; kdt < 2; ++kdt)
#pragma unroll
                    for (int j = 0; j < 4; ++j) *((bf16_t*)(CB + (16 * vt + 4 * fq + j) * 528) + 32 * wave + 16 * kdt + fr) = (bf16_t)(pk2(Cacc[vt][kdt][j], 0.f) & 0xffff);
        }
#undef STEP_R0
#undef SROWX
#undef SCAN_FETCH
#undef SCAN_SCALARS
#undef SCAN_FETCHQ
    }
}
#define LAS __attribute__((address_space(3)))
#define XB_TMO      128
#define XB_XCNT(j)  (256  + 64 * (j))
#define XB_XSUB(j)  (1280 + 64 * (j))
#define XB_XGEN(j)  (2304 + 64 * (j))
#define XB_TOP      3328
#define XB_TOPGEN   3392
#define XCD_BAR_WORDS 3456
#define XB_SPIN_CAP (1u << 18)

__device__ __forceinline__ unsigned xb_ld(unsigned* p)              { return __hip_atomic_load(p, __ATOMIC_RELAXED, __HIP_MEMORY_SCOPE_AGENT); }
__device__ __forceinline__ unsigned xb_add(unsigned* p, unsigned v) { return __hip_atomic_fetch_add(p, v, __ATOMIC_RELAXED, __HIP_MEMORY_SCOPE_AGENT); }
__device__ __forceinline__ unsigned xb_xcc_id() { return (unsigned)__builtin_amdgcn_s_getreg((3 << 11) | 20) & 0xFu; }
#define XB_SPIN(cond, bar) do { unsigned _sp = 0; while (cond) { __builtin_amdgcn_s_sleep(1); \
    if ((++_sp & 255u) == 0u) { if (xb_ld(&(bar)[XB_TMO])) break; if (_sp > XB_SPIN_CAP) { atomicAdd(&(bar)[XB_TMO], 1u); break; } } } } while (0)

struct XcdBarrier {
    unsigned* bar; unsigned x;
    volatile LAS unsigned* st;
};

__device__ __forceinline__ XcdBarrier xcd_barrier_post(unsigned* bar, volatile LAS unsigned* st) {
    XcdBarrier b; b.bar = bar; b.x = xb_xcc_id(); b.st = st;
    if (threadIdx.x == 0) (void)xb_add(&bar[XB_XCNT(b.x)], 1u);
    return b;
}
__device__ __forceinline__ void xcd_barrier_complete(unsigned* bar, unsigned x, unsigned& nloc, unsigned& nx) {
    const unsigned G = gridDim.x * gridDim.y * gridDim.z;
    unsigned sum, cnt, mine, sp = 0u;
    for (;;) {
        sum = 0u; cnt = 0u; mine = 0u;
#pragma unroll
        for (unsigned j = 0; j < 16; ++j) { const unsigned c = xb_ld(&bar[XB_XCNT(j)]); sum += c; cnt += (c > 0u) ? 1u : 0u; mine = (j == x) ? c : mine; }
        if (sum == G) break;
        __builtin_amdgcn_s_sleep(1);
        if ((++sp & 255u) == 0u) { if (xb_ld(&bar[XB_TMO])) break; if (sp > XB_SPIN_CAP) { atomicAdd(&bar[XB_TMO], 1u); break; } }
    }
    nloc = mine > 0u ? mine : 1u; nx = cnt > 0u ? cnt : 1u;
}

__device__ __forceinline__ void xcd_barrier(const XcdBarrier& b) {
    asm volatile("s_waitcnt vmcnt(0)" ::: "memory");
    __syncthreads();
    if (threadIdx.x == 0) {
        unsigned* bar = b.bar;
        __builtin_amdgcn_s_waitcnt(0);
        unsigned nloc = b.st[0], nx = b.st[1];
        if (nloc == 0u) { xcd_barrier_complete(bar, b.x, nloc, nx); b.st[0] = nloc; b.st[1] = nx; }
        const unsigned old = xb_add(&bar[XB_XSUB(b.x)], 1u);
        const unsigned gen = old / nloc;
        if (old + 1u == (gen + 1u) * nloc) {
            __builtin_amdgcn_fence(__ATOMIC_RELEASE, "agent");
            asm volatile("s_waitcnt vmcnt(0)" ::: "memory");
            const unsigned og = xb_add(&bar[XB_TOP], 1u);
            const unsigned tg = og / nx;
            if (og + 1u == (tg + 1u) * nx) xb_add(&bar[XB_TOPGEN], 1u);
            else XB_SPIN(xb_ld(&bar[XB_TOPGEN]) == tg, bar);
            __builtin_amdgcn_fence(__ATOMIC_ACQUIRE, "agent");
            xb_add(&bar[XB_XGEN(b.x)], 1u);
            asm volatile("s_waitcnt vmcnt(0)" ::: "memory");
        } else {
            XB_SPIN(xb_ld(&bar[XB_XGEN(b.x)]) == gen, bar);
            __builtin_amdgcn_fence(__ATOMIC_ACQUIRE, "agent");
            asm volatile("s_waitcnt vmcnt(0)" ::: "memory");
        }
    }
    __syncthreads();
}

struct Args { const float* in[25]; float* out; unsigned char* ws; };
#define GEMM_PHASE(EPI, g, S, E) pg8::gemm_phase<EPI, pg8::Order, true, true>((PG8_LAS unsigned char*)lds, g, S, E)
__global__ void __launch_bounds__(512, 2) fwd_megakernel(Args args) {
    extern __shared__ __attribute__((aligned(16))) unsigned char lds[];
    cg::grid_group grid = cg::this_grid();
    Ctx C; C.tab = lds + LDS_BYTES - 256;
    if (threadIdx.x == 0) {
#pragma unroll
        for (int i = 0; i < 25; ++i) *(const float**)(C.tab + 8 * i) = args.in[i];
        *(float**)(C.tab + 8 * 25) = args.out; *(unsigned char**)(C.tab + 8 * 26) = args.ws; }
    if (threadIdx.x < 2) ((volatile LAS unsigned*)(lds + LDS_BYTES - 512))[threadIdx.x] = 0u;
    __syncthreads();
    const int G = gridDim.x, bid = blockIdx.x;
    (void)xcd_barrier_post((unsigned*)(args.ws + WS_BAR), (volatile LAS unsigned*)(lds + LDS_BYTES - 512));
#define GSYNC() do { XcdBarrier xb_; xb_.bar = (unsigned*)(C.ws() + WS_BAR); xb_.x = xb_xcc_id(); xb_.st = (volatile LAS unsigned*)(lds + LDS_BYTES - 512); xcd_barrier(xb_); } while (0)
#define WF(off) ((float*)(w + (off)))
#define WH(off) ((bf16_t*)(w + (off)))
    phase_p0(C, lds, G);
    if (args.ws == nullptr) grid.sync();
    GSYNC();
    phase_p0b(C, lds, G);
    GSYNC();
#pragma unroll
    for (int l = 0; l < 2; ++l) {
        const size_t mods_l = WS_MODS + (size_t)l * 5 * NMODC * 4;
        { unsigned char* w = C.ws();
          pg8::Gemm g{WH(WS_XN), WH(WS_WGU + (size_t)(l * 2 + 0) * 5632 * D * 2), M, 5632, D}; pg8::Order S; S.init(M, 5632, D, G, bid);
          pg8::EpiFFNUp E{WF(WS_RS + (size_t)(l * 3 + 0) * M * 4), WF(WS_SB + (size_t)((l * 3 + 0) * 5) * 5632 * 4), WH(WS_ACT)}; GEMM_PHASE(pg8::EpiFFNUp, g, S, E); }
        GSYNC();
        { unsigned char* w = C.ws(); float* xo = C.out();
          pg8::Gemm g{WH(WS_ACT), WH(WS_WD + (size_t)(l * 2 + 0) * D * FF * 2), M, D, FF}; pg8::Order S; S.init(ML, D, FF, G, bid, 176, 64, 0, 4, 11);
          pg8::EpiResid<1> E{l == 0 ? C.in(0) : xo, l == 0 ? C.in(2) : WF(WS_XC), xo, WF(WS_XC), WF(mods_l + 2 * D * 4), C.in(9) + l * D, WF(mods_l + 4 * D * 4), WH(WS_XN), WF(WS_RS + (size_t)(l * 3 + 1) * M * 4), WF(WS_PART)};
          GEMM_PHASE(pg8::EpiResid<1>, g, S, E); }
        GSYNC();
        { const float* bc = l == 0 ? C.in(2) : (const float*)(C.ws() + WS_XC); phase_ctx_fin<11>(C, G, 0.5f, bc, mods_l + 2 * D * 4, C.in(9) + l * D, mods_l + 4 * D * 4, WS_RS + (size_t)(l * 3 + 1) * M * 4); GSYNC(); }
        if (l == 0) {
            { unsigned char* w = C.ws();
              pg8::Gemm g{WH(WS_XN), WH(WS_WEIN), M, EVIN, D}; pg8::Order S; S.init(M, EVIN, D, G, bid);
              pg8::EpiEvenIn E{WF(WS_RS + (size_t)1 * M * 4), WF(WS_SB + (size_t)(1 * 5) * 5632 * 4), WF(WS_ROPE), WF(WS_ROPE + 4096), WH(WS_U), WH(WS_Q), WH(WS_KV)};
              GEMM_PHASE(pg8::EpiEvenIn, g, S, E); }
            GSYNC();
            phase_even_mix(C, lds, G);
            GSYNC();
        } else {
            phase_gates(C, lds, G);
            { unsigned char* w = C.ws();
              pg8::Gemm g{WH(WS_XN), WH(WS_WOIN), M, 3072, D}; pg8::Order S; S.init(ML, 3072, D, G, bid, 32, 64, 4, 8, 1);
              pg8::EpiOddIn E{WF(WS_RS + (size_t)4 * M * 4), WF(WS_SB + (size_t)(4 * 5) * 5632 * 4), WH(WS_QKV)}; GEMM_PHASE(pg8::EpiOddIn, g, S, E); }
            GSYNC();
            phase_scan(C, lds, G);
            GSYNC();
            phase_hn(C, G);
            GSYNC();
            { unsigned char* w = C.ws();
              pg8::Gemm g{WH(WS_XN), WH(WS_WOIN + (size_t)3072 * D * 2), ML, D, D}; pg8::Order S; S.init(ML, D, D, G, bid);
              pg8::EpiOddGate E{WF(WS_RS + (size_t)4 * M * 4), WF(WS_SB + (size_t)(4 * 5) * 5632 * 4), WH(WS_HN), WH(WS_MIXA_O)}; GEMM_PHASE(pg8::EpiOddGate, g, S, E); }
            GSYNC();
        }
        const int Mr = l == 0 ? M : ML;
        { unsigned char* w = C.ws(); float* xo = C.out();
          pg8::Gemm g{WH(l == 0 ? WS_MIXA_E : WS_MIXA_O), WH(l == 0 ? WS_WEOUT : WS_WOOUT), Mr, D, D}; pg8::Order S; S.init(ML, D, D, G, bid, l == 0 ? 64 : 0, 64, 0, 4, 4);
          pg8::EpiResid<2> E{xo, WF(WS_XC), xo, WF(WS_XC), WF(mods_l + 5 * D * 4), C.in(10) + l * D, WF(mods_l + 7 * D * 4), WH(WS_XN), WF(WS_RS + (size_t)(l * 3 + 2) * M * 4), l == 0 ? WF(WS_PART) : nullptr};
          GEMM_PHASE(pg8::EpiResid<2>, g, S, E); }
        GSYNC();
        if (l == 0) { phase_ctx_fin<4>(C, G, 1.0f, (const float*)(C.ws() + WS_XC), mods_l + 5 * D * 4, C.in(10) + l * D, mods_l + 7 * D * 4, WS_RS + (size_t)(l * 3 + 2) * M * 4); GSYNC(); }
        { unsigned char* w = C.ws();
          pg8::Gemm g{WH(WS_XN), WH(WS_WGU + (size_t)(l * 2 + 1) * 5632 * D * 2), Mr, 5632, D}; pg8::Order S; S.init(Mr, 5632, D, G, bid);
          pg8::EpiFFNUp E{WF(WS_RS + (size_t)(l * 3 + 2) * M * 4), WF(WS_SB + (size_t)((l * 3 + 2) * 5) * 5632 * 4), WH(WS_ACT)}; GEMM_PHASE(pg8::EpiFFNUp, g, S, E); }
        GSYNC();
        { unsigned char* w = C.ws(); float* xo = C.out();
          pg8::Gemm g{WH(WS_ACT), WH(WS_WD + (size_t)(l * 2 + 1) * D * FF * 2), Mr, D, FF}; pg8::Order S; S.init(ML, D, FF, G, bid, l == 0 ? 176 : 0, 64, 0, 4, 11);
          pg8::EpiResid<1> E{xo, WF(WS_XC), xo, WF(WS_XC), WF(mods_l + 8 * D * 4), l == 0 ? C.in(6) + D : nullptr, WF(WS_MODS + (size_t)5 * NMODC * 4 + 1 * D * 4), WH(WS_XN), WF(WS_RS + (size_t)(l == 0 ? 3 : 6) * M * 4), l == 0 ? WF(WS_PART) : nullptr};
          GEMM_PHASE(pg8::EpiResid<1>, g, S, E); }
        GSYNC();
        if (l == 0) { phase_ctx_fin<11>(C, G, 0.5f, (const float*)(C.ws() + WS_XC), mods_l + 8 * D * 4, C.in(6) + D, WS_MODS + (size_t)5 * NMODC * 4 + 1 * D * 4, WS_RS + (size_t)3 * M * 4); GSYNC(); }
    }
    phase_final(C, G);
}

extern "C" void kernel_launch(void* const* d_in, const int* in_sizes, int n_in, void* d_out, int out_size, void* d_ws, size_t ws_size, hipStream_t stream) {
    static int grid = 0;
    if (grid == 0) {
        if (n_in != 25 || ws_size < WS_END) { fprintf(stderr, "kernel_launch: unexpected n_in %d / ws_size %zu (need %zu)\n", n_in, ws_size, (size_t)WS_END); grid = -1; return; }
        int dev = 0, cus = 0, per_cu = 0;
        hipGetDevice(&dev);
        hipDeviceGetAttribute(&cus, hipDeviceAttributeMultiprocessorCount, dev);
        hipFuncSetAttribute((const void*)fwd_megakernel, hipFuncAttributeMaxDynamicSharedMemorySize, LDS_BYTES);
        if (hipOccupancyMaxActiveBlocksPerMultiprocessor(&per_cu, (const void*)fwd_megakernel, 512, LDS_BYTES) != hipSuccess || per_cu < 1) per_cu = 1;
        (void)hipGetLastError();
        grid = cus * per_cu;
    }
    if (grid < 0) return;
    (void)hipMemsetAsync(d_ws, 0, 4 * MiB, stream);
    Args a{};
    for (int i = 0; i < 25; ++i) a.in[i] = (const float*)d_in[i];
    a.out = (float*)d_out; a.ws = (unsigned char*)d_ws;
    void* kargs[] = {&a};
    hipError_t e = hipLaunchCooperativeKernel((const void*)fwd_megakernel, dim3(grid), dim3(512), kargs, LDS_BYTES, stream);
    if (e != hipSuccess) fprintf(stderr, "cooperative launch failed: %s (grid %d)\n", hipGetErrorString(e), grid);
}
```

```cpp
#include <hip/hip_runtime.h>
#include <hip/hip_cooperative_groups.h>
#include <cstdio>
#include <cstdint>
namespace cg = cooperative_groups;
typedef unsigned short bf16_t;
typedef short bf16x8 __attribute__((ext_vector_type(8)));
typedef short s16x4 __attribute__((ext_vector_type(4)));
typedef float f32x4 __attribute__((ext_vector_type(4)));
typedef float f32x2 __attribute__((ext_vector_type(2)));
typedef unsigned u32x4 __attribute__((ext_vector_type(4)));
typedef unsigned u32x2 __attribute__((ext_vector_type(2)));
typedef __bf16 bf16x2_t __attribute__((ext_vector_type(2)));
__device__ __forceinline__ unsigned pk2(float lo, float hi) { f32x2 v = {lo, hi}; bf16x2_t b = __builtin_convertvector(v, bf16x2_t); return __builtin_bit_cast(unsigned, b); }
__device__ __forceinline__ float bflo(unsigned u) { return __uint_as_float(u << 16); }
__device__ __forceinline__ float bfhi(unsigned u) { return __uint_as_float(u & 0xffff0000u); }
__device__ __forceinline__ float bf2f(bf16_t u) { return __uint_as_float(((unsigned)u) << 16); }
__device__ __forceinline__ float wave_sum(float v) {
#pragma unroll
    for (int o = 1; o < 64; o <<= 1) v += __shfl_xor(v, o);
    return v;
}
__device__ __forceinline__ float sigmoidf_(float x) { return __builtin_amdgcn_rcpf(1.f + __expf(-x)); }
__device__ __forceinline__ float siluf_(float x) { return x * sigmoidf_(x); }

__device__ __forceinline__ int tid_opaque() { int t = threadIdx.x; asm volatile("" : "+v"(t)); return t; }
constexpr int D = 1024, NB = 4, SEQ = 4096, CTXL = 256, ML = NB * SEQ, MC = NB * CTXL, M = ML + MC, FF = 2816, NMODC = 9 * D;
constexpr int EVIN = 1792, ODIN = 4112, ODN = 4096;
constexpr float EPS = 1e-6f;
constexpr float QSCALE = 0.125f * 1.4426950408889634f;
constexpr float LOG2E = 1.4426950408889634f;
constexpr size_t MiB = 1u << 20;
constexpr size_t WS_MODS = 0;
constexpr size_t WS_SB = 512 * 1024;
constexpr size_t WS_RS = 1536 * 1024;
constexpr size_t WS_GATES = 2 * MiB;
constexpr size_t WS_ROPE = 2 * MiB + 1536 * 1024;
constexpr size_t WS_BAR = 3 * MiB + 768 * 1024;
constexpr size_t WS_QCTR = 3 * MiB + 896 * 1024;
constexpr size_t WS_XC = 4 * MiB;
constexpr size_t WS_WGU = 8 * MiB;
constexpr size_t WS_WD = WS_WGU + 44 * MiB;
constexpr size_t WS_WEIN = WS_WD + 22 * MiB;
constexpr size_t WS_WEOUT = WS_WEIN + 3 * MiB + 512 * 1024;
constexpr size_t WS_WOIN = WS_WEOUT + 2 * MiB;
constexpr size_t WS_WOOUT = WS_WOIN + 8 * MiB;
constexpr size_t WS_XN = 90 * MiB;
constexpr size_t WS_BIG = 124 * MiB;
static_assert(WS_WOOUT + 2 * MiB <= WS_XN, "weights fit");
constexpr size_t WS_ACT = WS_BIG;
constexpr size_t WS_U = WS_BIG;
constexpr size_t WS_Q = WS_BIG + 17 * MiB;
constexpr size_t WS_KV = WS_BIG + 34 * MiB;
constexpr size_t WS_MIXA_E = WS_BIG + 43 * MiB;
constexpr size_t WS_QKV = WS_BIG;
constexpr size_t WS_HF = WS_BIG + 102 * MiB;
constexpr size_t WS_HB = WS_BIG + 134 * MiB;
constexpr size_t WS_HN = WS_QKV;
constexpr size_t WS_MIXA_O = WS_QKV + 34 * MiB;
constexpr size_t WS_PART = WS_BIG + 94 * MiB;
constexpr size_t WS_END = WS_BIG + 166 * MiB;
constexpr size_t WS_SCG = WS_END;
constexpr size_t WS_END2 = WS_SCG + (size_t)256 * 34 * 384 * 4;
constexpr int LDS_BYTES = 147456;
namespace pg8 {
#define PG8_LAS __attribute__((address_space(3)))
typedef unsigned short bf16_t;
typedef short bf16x8 __attribute__((ext_vector_type(8)));
typedef float f32x4 __attribute__((ext_vector_type(4)));
typedef unsigned u32x4 __attribute__((ext_vector_type(4)));
constexpr int BM = 256, BK = 64, HALF = 128, HTB = HALF * BK * 2  , STAGE_BYTES = 8 * HTB, NXCD = 8, WGM = 8;

__host__ __device__ __forceinline__ int lds_byte(int r, int c) { const int st = (r >> 4) * 2 + (c >> 5), rr = r & 15, cc = c & 31, ob = rr * 64 + cc * 2; return st * 1024 + (ob ^ (((ob >> 9) & 1) << 5)); }
__host__ __device__ __forceinline__ void stage_rc(int b, int& R, int& C) { const int st = b / 1024, sb = b % 1024, swz = sb ^ (((sb >> 9) & 1) << 5); R = (st >> 1) * 16 + swz / 64; C = (st & 1) * 32 + (swz % 64) / 2; }
__host__ __device__ __forceinline__ int perm32(int rho) { const int n = rho >> 4, i = rho & 15; return 8 * (i >> 2) + 4 * n + (i & 3); }

struct Unit { int pm, pn, k0t, ntu; };
struct Gemm { const bf16_t* A; const bf16_t* Bt; int M, N, K; };

struct StaticOrder {
    int nM, nN, nwg, G, c;
    __host__ __device__ void init(int M, int N, int G_, int c_) { nM = M / BM; nN = N / BM; nwg = nM * nN; G = G_; c = c_; }
    __host__ __device__ bool next(int i, Unit& u) const {
        const long L = (long)i * G + c; if (L >= nwg) return false;
        int wgid = (int)L; { const int q = nwg / NXCD, r = nwg % NXCD, xcd = wgid % NXCD, off = wgid / NXCD; wgid = (xcd < r ? xcd * (q + 1) : r * (q + 1) + (xcd - r) * q) + off; }
        const int nig = WGM * nN, gid = wgid / nig, fm = gid * WGM, gsz = (nM - fm) < WGM ? (nM - fm) : WGM;
        u.pm = fm + ((wgid % nig) % gsz); u.pn = (wgid % nig) / gsz; return true;
    }
    __device__ __forceinline__ void a_ready(const Unit&) const {}
    __device__ __forceinline__ void done(const Unit&) const {}
};

struct Order {
    int nM, nN, nwg, G, c, ntf, nx, xpm0, xpn0, xnn, nsl;
    __device__ void init(int Mr, int N, int K, int G_, int c_, int nx_ = 0, int xpm0_ = 0, int xpn0_ = 0, int xnn_ = 1, int nsl_ = 1) { nM = Mr / BM; nN = N / BM; nwg = nM * nN; G = G_; c = c_; ntf = K / BK; nx = nx_; xpm0 = xpm0_; xpn0 = xpn0_; xnn = xnn_; nsl = nsl_; }
    __device__ bool next(int i, Unit& u) const {
        const long L = (long)i * G + c; if (L >= nwg + nx) return false;
        u.k0t = 0; u.ntu = ntf;
        if (L >= nwg) { const int e = (int)L - nwg, cu = e / nsl, sl = e % nsl; u.pm = xpm0 + cu / xnn; u.pn = xpn0 + cu % xnn; u.ntu = ntf / nsl; u.k0t = sl * u.ntu; return true; }
        int wgid = (int)L; { const int q = nwg / NXCD, r = nwg % NXCD, xcd = wgid % NXCD, off = wgid / NXCD; wgid = (xcd < r ? xcd * (q + 1) : r * (q + 1) + (xcd - r) * q) + off; }
        const int nig = WGM * nN, gid = wgid / nig, fm = gid * WGM, gsz = (nM - fm) < WGM ? (nM - fm) : WGM;
        u.pm = fm + ((wgid % nig) % gsz); u.pn = (wgid % nig) / gsz; return true;
    }
    __device__ __forceinline__ void a_ready(const Unit&) const {}
    __device__ __forceinline__ void done(const Unit&) const {}
};
__device__ __forceinline__ float rstd_of(float ssq) { return __builtin_amdgcn_rsqf(ssq * (1.0f / 1024.0f) + ::EPS); }
__device__ __forceinline__ int cond_of(int pm) { return pm < 64 ? (pm >> 4) : 4; }

struct EpiFFNUp {
    static constexpr bool PERM = true, AFTER_DRAIN = false;
    const float* rs; const float* sb; bf16_t* act;
    __device__ __forceinline__ void operator()(const f32x4 (&acc)[2][2][4][2], const Unit& u, int wr, int wc, int fr, int fq) const {
        const int ci = cond_of(u.pm);
        const float* sbp = sb + ci * 5632 + u.pn * 256 + wc * 32 + 8 * fq;
        const f32x4 bg0 = *(const f32x4*)(sbp), bg1 = *(const f32x4*)(sbp + 4), bu0 = *(const f32x4*)(sbp + 128), bu1 = *(const f32x4*)(sbp + 132);
        const int ocol = u.pn * 128 + wc * 32 + 8 * fq;
#pragma unroll
        for (int ai = 0; ai < 2; ++ai)
#pragma unroll
            for (int m = 0; m < 4; ++m) {
                const int row = u.pm * BM + ai * HALF + wr * 64 + m * 16 + fr;
                const float r = rstd_of(rs[row]);
                const f32x4 g0 = acc[ai][0][m][0] * r + bg0, g1 = acc[ai][0][m][1] * r + bg1, u0 = acc[ai][1][m][0] * r + bu0, u1 = acc[ai][1][m][1] * r + bu1;
                f32x4 e0 = g0 * (-1.4426950408889634f), e1 = g1 * (-1.4426950408889634f);
#pragma unroll
                for (int i = 0; i < 4; ++i) { e0[i] = __builtin_amdgcn_exp2f(e0[i]); e1[i] = __builtin_amdgcn_exp2f(e1[i]); }
                f32x4 d0 = e0 + 1.0f, d1 = e1 + 1.0f;
#pragma unroll
                for (int i = 0; i < 4; ++i) { d0[i] = __builtin_amdgcn_rcpf(d0[i]); d1[i] = __builtin_amdgcn_rcpf(d1[i]); }
                const f32x4 o0 = (g0 * u0) * d0, o1 = (g1 * u1) * d1;
                u32x4 w;
                w.x = ::pk2(o0[0], o0[1]); w.y = ::pk2(o0[2], o0[3]); w.z = ::pk2(o1[0], o1[1]); w.w = ::pk2(o1[2], o1[3]);
                *(u32x4*)(act + (size_t)row * ::FF + ocol) = w;
            }
    }
};
template <int GC2> struct EpiResid {
    static constexpr bool PERM = true, AFTER_DRAIN = false;
    const float* base_l; const float* base_c; float* out_l; float* out_c;
    const float* gate;
    const float* ng; const float* nscale;
    bf16_t* xn; float* rs_next;
    float* part;
    __device__ __forceinline__ void operator()(const f32x4 (&acc)[2][2][4][2], const Unit& u, int wr, int wc, int fr, int fq) const {
        const int ci = cond_of(u.pm); constexpr float gcoef = 0.5f * GC2;
        const bool lat = u.pm < 64;
        const bool slice = !lat && part != nullptr;
        const float* bp = lat ? base_l : base_c; float* op = slice ? part + (size_t)(u.k0t / u.ntu) * ::MC * ::D : (lat ? out_l : out_c);
        const float* ngu = slice ? nullptr : ng; float* rsu = slice ? nullptr : rs_next;
        const int rbase = lat ? u.pm * BM : (u.pm - 64) * BM;
        const int col0 = u.pn * BM + wc * 32 + 8 * fq;
        float ss[2][4];
#pragma unroll
        for (int ai = 0; ai < 2; ++ai)
#pragma unroll
            for (int m = 0; m < 4; ++m) ss[ai][m] = 0.f;
#pragma unroll
        for (int bj = 0; bj < 2; ++bj) {
            const int col = col0 + bj * HALF;
            f32x4 g0 = (f32x4){1.f, 1.f, 1.f, 1.f}, g1 = g0;
            if (!slice) { g0 = *(const f32x4*)(gate + ci * ::NMODC + col) * gcoef; g1 = *(const f32x4*)(gate + ci * ::NMODC + col + 4) * gcoef; }
            f32x4 s0 = (f32x4){0.f, 0.f, 0.f, 0.f}, s1 = s0;
            if (ngu) { s0 = *(const f32x4*)(ng + col) * (*(const f32x4*)(nscale + ci * ::NMODC + col) + 1.0f); s1 = *(const f32x4*)(ng + col + 4) * (*(const f32x4*)(nscale + ci * ::NMODC + col + 4) + 1.0f); }
#pragma unroll
            for (int ai = 0; ai < 2; ++ai)
#pragma unroll
                for (int m = 0; m < 4; ++m) {
                    const int rl = rbase + ai * HALF + wr * 64 + m * 16 + fr;
                    const int rg = u.pm * BM + ai * HALF + wr * 64 + m * 16 + fr;
                    const size_t off = (size_t)rl * ::D + col;
                    f32x4 b0 = (f32x4){0.f, 0.f, 0.f, 0.f}, b1 = b0;
                    if (!slice) { b0 = *(const f32x4*)(bp + off); b1 = *(const f32x4*)(bp + off + 4); }
                    const f32x4 x0 = b0 + g0 * acc[ai][bj][m][0], x1 = b1 + g1 * acc[ai][bj][m][1];
                    *(f32x4*)(op + off) = x0; *(f32x4*)(op + off + 4) = x1;
                    ss[ai][m] += (x0[0] * x0[0] + x0[1] * x0[1]) + (x0[2] * x0[2] + x0[3] * x0[3]) + (x1[0] * x1[0] + x1[1] * x1[1]) + (x1[2] * x1[2] + x1[3] * x1[3]);
                    if (ngu) { const f32x4 y0 = x0 * s0, y1 = x1 * s1; u32x4 w; w.x = ::pk2(y0[0], y0[1]); w.y = ::pk2(y0[2], y0[3]); w.z = ::pk2(y1[0], y1[1]); w.w = ::pk2(y1[2], y1[3]);
                        *(u32x4*)(xn + (size_t)rg * ::D + col) = w; }
                }
        }
        if (rsu) {
#pragma unroll
            for (int ai = 0; ai < 2; ++ai)
#pragma unroll
                for (int m = 0; m < 4; ++m) { float t = ss[ai][m]; t += __shfl_xor(t, 16); t += __shfl_xor(t, 32); if (fq == 0) atomicAdd(rsu + u.pm * BM + ai * HALF + wr * 64 + m * 16 + fr, t); }
        }
    }
};
struct EpiEvenIn {
    static constexpr bool PERM = false, AFTER_DRAIN = false;
    const float* rs; const float* sb; const float* rcos; const float* rsin; bf16_t* U; bf16_t* Q; bf16_t* KV;
    __device__ __forceinline__ void operator()(const f32x4 (&acc)[2][2][4][2], const Unit& u, int wr, int wc, int fr, int fq) const {
        const int ci = cond_of(u.pm); const bool lat = u.pm < 64;
        const float* sbp = sb + ci * 5632 + u.pn * 256 + wc * 32 + 4 * fq;
        f32x4 bv[2][2];
#pragma unroll
        for (int bj = 0; bj < 2; ++bj)
#pragma unroll
            for (int n = 0; n < 2; ++n) bv[bj][n] = *(const f32x4*)(sbp + bj * HALF + 16 * n);
        const int cw = wc * 32 + 4 * fq;
#pragma unroll
        for (int ai = 0; ai < 2; ++ai)
#pragma unroll
            for (int m = 0; m < 4; ++m) {
                const int row = u.pm * BM + ai * HALF + wr * 64 + m * 16 + fr;
                const float r = rstd_of(rs[row]);
                f32x4 h[2][2];
#pragma unroll
                for (int bj = 0; bj < 2; ++bj)
#pragma unroll
                    for (int n = 0; n < 2; ++n) h[bj][n] = acc[ai][bj][m][n] * r + bv[bj][n];
                if (u.pn < 4) {
#pragma unroll
                    for (int n = 0; n < 2; ++n) { const f32x4 v = h[0][n], g = h[1][n]; u32x2 w; w.x = ::pk2(v[0] * ::sigmoidf_(g[0]), v[1] * ::sigmoidf_(g[1])); w.y = ::pk2(v[2] * ::sigmoidf_(g[2]), v[3] * ::sigmoidf_(g[3]));
                        *(u32x2*)(U + (size_t)row * 512 + u.pn * 128 + cw + 16 * n) = w; }
                } else {
                    f32x4 cs = (f32x4){1.f, 1.f, 1.f, 1.f}, sn = (f32x4){0.f, 0.f, 0.f, 0.f};
                    if (lat) { const int pos = row & (::SEQ - 1); const int p = (wc & 1) ? (pos & 63) : (pos >> 6); cs = *(const f32x4*)(rcos + p * 16 + 4 * fq); sn = *(const f32x4*)(rsin + p * 16 + 4 * fq); }
                    if (u.pn < 6) {
#pragma unroll
                        for (int bj = 0; bj < 2; ++bj) { const f32x4 x1 = h[bj][0], x2 = h[bj][1]; const f32x4 o1 = (x1 * cs - x2 * sn) * ::QSCALE, o2 = (x2 * cs + x1 * sn) * ::QSCALE;
                            bf16_t* qp = Q + (size_t)row * 512 + (u.pn - 4) * 256 + bj * HALF + cw;
                            u32x2 w; w.x = ::pk2(o1[0], o1[1]); w.y = ::pk2(o1[2], o1[3]); *(u32x2*)(qp) = w; w.x = ::pk2(o2[0], o2[1]); w.y = ::pk2(o2[2], o2[3]); *(u32x2*)(qp + 16) = w; }
                    } else {
                        { const f32x4 x1 = h[0][0], x2 = h[0][1]; const f32x4 o1 = x1 * cs - x2 * sn, o2 = x2 * cs + x1 * sn; bf16_t* kp = KV + (size_t)row * 256 + cw;
                            u32x2 w; w.x = ::pk2(o1[0], o1[1]); w.y = ::pk2(o1[2], o1[3]); *(u32x2*)(kp) = w; w.x = ::pk2(o2[0], o2[1]); w.y = ::pk2(o2[2], o2[3]); *(u32x2*)(kp + 16) = w; }
                        { bf16_t* vp = KV + (size_t)row * 256 + 128 + cw;
#pragma unroll
                            for (int n = 0; n < 2; ++n) { const f32x4 v = h[1][n]; u32x2 w; w.x = ::pk2(v[0], v[1]); w.y = ::pk2(v[2], v[3]); *(u32x2*)(vp + 16 * n) = w; } }
                    }
                }
            }
    }
};
struct EpiOddIn {
    static constexpr bool PERM = true, AFTER_DRAIN = false;
    const float* rs; const float* sb; bf16_t* QKV;
    __device__ __forceinline__ void operator()(const f32x4 (&acc)[2][2][4][2], const Unit& u, int wr, int wc, int fr, int fq) const {
        const int ci = cond_of(u.pm);
        const float* sbp = sb + ci * 5632 + u.pn * 256 + wc * 32 + 8 * fq;
        const int which = u.pn >> 2; const float sc = which == 1 ? 0.0625f : 1.0f;
        bf16_t* dst = QKV + (size_t)which * ::M * ::D + (u.pn & 3) * 256 + wc * 32 + 8 * fq;
        f32x4 bv[2][2];
#pragma unroll
        for (int bj = 0; bj < 2; ++bj)
#pragma unroll
            for (int n = 0; n < 2; ++n) bv[bj][n] = *(const f32x4*)(sbp + bj * HALF + 4 * n);
#pragma unroll
        for (int ai = 0; ai < 2; ++ai)
#pragma unroll
            for (int m = 0; m < 4; ++m) {
                const int row = u.pm * BM + ai * HALF + wr * 64 + m * 16 + fr;
                const float r = rstd_of(rs[row]);
#pragma unroll
                for (int bj = 0; bj < 2; ++bj) { const f32x4 v0 = (acc[ai][bj][m][0] * r + bv[bj][0]) * sc, v1 = (acc[ai][bj][m][1] * r + bv[bj][1]) * sc;
                    u32x4 w; w.x = ::pk2(v0[0], v0[1]); w.y = ::pk2(v0[2], v0[3]); w.z = ::pk2(v1[0], v1[1]); w.w = ::pk2(v1[2], v1[3]);
                    *(u32x4*)(dst + (size_t)row * ::D + bj * HALF) = w; }
            }
    }
};
struct EpiOddGate {
    static constexpr bool PERM = true, AFTER_DRAIN = false;
    const float* rs; const float* sb; const bf16_t* HN; bf16_t* MIXA;
    __device__ __forceinline__ void operator()(const f32x4 (&acc)[2][2][4][2], const Unit& u, int wr, int wc, int fr, int fq) const {
        const int ci = cond_of(u.pm);
        const int col0 = u.pn * 256 + wc * 32 + 8 * fq;
        const float* sbp = sb + ci * 5632 + 3072 + col0;
        f32x4 bv[2][2];
#pragma unroll
        for (int bj = 0; bj < 2; ++bj)
#pragma unroll
            for (int n = 0; n < 2; ++n) bv[bj][n] = *(const f32x4*)(sbp + bj * HALF + 4 * n);
#pragma unroll
        for (int ai = 0; ai < 2; ++ai)
#pragma unroll
            for (int m = 0; m < 4; ++m) {
                const int row = u.pm * BM + ai * HALF + wr * 64 + m * 16 + fr;
                const float r = rstd_of(rs[row]);
#pragma unroll
                for (int bj = 0; bj < 2; ++bj) { const f32x4 v0 = acc[ai][bj][m][0] * r + bv[bj][0], v1 = acc[ai][bj][m][1] * r + bv[bj][1];
                    const u32x4 hn = *(const u32x4*)(HN + (size_t)row * ::D + col0 + bj * HALF);
                    u32x4 w; w.x = ::pk2(::sigmoidf_(v0[0]) * ::bflo(hn.x), ::sigmoidf_(v0[1]) * ::bfhi(hn.x)); w.y = ::pk2(::sigmoidf_(v0[2]) * ::bflo(hn.y), ::sigmoidf_(v0[3]) * ::bfhi(hn.y));
                    w.z = ::pk2(::sigmoidf_(v1[0]) * ::bflo(hn.z), ::sigmoidf_(v1[1]) * ::bfhi(hn.z)); w.w = ::pk2(::sigmoidf_(v1[2]) * ::bflo(hn.w), ::sigmoidf_(v1[3]) * ::bfhi(hn.w));
                    *(u32x4*)(MIXA + (size_t)row * ::D + col0 + bj * HALF) = w; }
            }
    }
};
template <class Epi, class Sched, bool ALIGN_EPI = false, bool SP2 = false>
__device__ __forceinline__ void gemm_phase(PG8_LAS unsigned char* lds, const Gemm g, const Sched& S, const Epi& E) {
    const int tid = ::tid_opaque(), wid = __builtin_amdgcn_readfirstlane(tid >> 6), lane = tid & 63, wr = wid >> 2, wc = wid & 3, fr = lane & 15, fq = lane >> 4;
    const int K = g.K, nt = K / BK;
    unsigned voffA[2], voffB[2];
#pragma unroll
    for (int i = 0; i < 2; ++i) { int R, C; stage_rc(tid * 16 + i * 8192, R, C); const int Rb = Epi::PERM ? ((R & ~31) + perm32(R & 31)) : R;
        voffA[i] = (unsigned)(R * K + C) * 2u; voffB[i] = (unsigned)(Rb * K + C) * 2u; }
    const size_t kstep = (size_t)(BK * 2);
    const size_t hstep = (size_t)HALF * K * 2;
    const size_t tstep = 2 * hstep;
    const unsigned ldsw = (unsigned)wid * 1024u;
    const int aoff = lds_byte(wr * 64 + fr, fq * 8), boff = lds_byte(wc * 32 + fr, fq * 8);
#define PG8_SA(b, h) (((b) * 2 + (h)) * HTB)
#define PG8_SB(b, h) ((4 + (b) * 2 + (h)) * HTB)
#define PG8_STAGE(bufoff, gbase, voff) do { _Pragma("unroll") for (int _i = 0; _i < 2; ++_i) \
        __builtin_amdgcn_global_load_lds((const unsigned*)((const char*)(gbase) + (voff)[_i]), (PG8_LAS unsigned*)(lds + (bufoff) + ldsw + _i * 8192), 16, 0, 0); } while (0)
#define PG8_LDA(dst, b, h) do { _Pragma("unroll") for (int m = 0; m < 4; ++m) _Pragma("unroll") for (int k = 0; k < 2; ++k) dst[m][k] = *(const PG8_LAS bf16x8*)(lds + PG8_SA(b, h) + aoff + m * 2048 + k * 1024); } while (0)
#define PG8_LDB(dst, b, h) do { _Pragma("unroll") for (int n = 0; n < 2; ++n) _Pragma("unroll") for (int k = 0; k < 2; ++k) dst[n][k] = *(const PG8_LAS bf16x8*)(lds + PG8_SB(b, h) + boff + n * 2048 + k * 1024); } while (0)
#define PG8_MMA(ai, bj, At, Bt) do { __builtin_amdgcn_s_setprio(1); _Pragma("unroll") for (int m = 0; m < 4; ++m) _Pragma("unroll") for (int n = 0; n < 2; ++n) _Pragma("unroll") for (int k = 0; k < 2; ++k) \
        acc[ai][bj][m][n] = __builtin_amdgcn_mfma_f32_16x16x32_bf16(Bt[n][k], At[m][k], acc[ai][bj][m][n], 0, 0, 0); __builtin_amdgcn_s_setprio(0); } while (0)
#define PG8_WAIT_V(n) asm volatile("s_waitcnt vmcnt(" #n ")" ::: "memory")
#define PG8_WAIT_L(n) asm volatile("s_waitcnt lgkmcnt(" #n ")" ::: "memory")
#define PG8_BAR __builtin_amdgcn_s_barrier()
#define PG8_SCHED __builtin_amdgcn_sched_barrier(0)
    Unit cur, nxt; int ui = 0;
    if (!S.next(0, cur)) return;
    int cnt = cur.ntu;
    f32x4 acc[2][2][4][2];
#pragma unroll
    for (int a = 0; a < 2; ++a)
#pragma unroll
        for (int b = 0; b < 2; ++b)
#pragma unroll
            for (int m = 0; m < 4; ++m)
#pragma unroll
                for (int n = 0; n < 2; ++n) acc[a][b][m][n] = (f32x4){0.f, 0.f, 0.f, 0.f};
    bf16x8 At[4][2], B0[2][2], B1[2][2];
    const char* cA = (const char*)g.A + (size_t)cur.pm * tstep + (size_t)cur.k0t * kstep; const char* cB = (const char*)g.Bt + (size_t)cur.pn * tstep + (size_t)cur.k0t * kstep;
    S.a_ready(cur);
    if constexpr (SP2) {
        PG8_STAGE(PG8_SB(0, 0), cB, voffB); PG8_STAGE(PG8_SB(0, 1), cB + hstep, voffB); PG8_STAGE(PG8_SA(0, 0), cA, voffA); PG8_STAGE(PG8_SA(0, 1), cA + hstep, voffA);
        if (wr == 1) PG8_BAR;
        PG8_WAIT_V(2); PG8_BAR;
        PG8_STAGE(PG8_SB(1, 0), cB + kstep, voffB); PG8_STAGE(PG8_SA(1, 0), cA + kstep, voffA); PG8_STAGE(PG8_SB(1, 1), cB + hstep + kstep, voffB);
        PG8_WAIT_V(6); PG8_BAR;
    } else {
        PG8_STAGE(PG8_SB(0, 0), cB, voffB); PG8_STAGE(PG8_SA(0, 0), cA, voffA); PG8_STAGE(PG8_SB(0, 1), cB + hstep, voffB); PG8_STAGE(PG8_SA(0, 1), cA + hstep, voffA);
        if (wr == 1) PG8_BAR;
        PG8_WAIT_V(4); PG8_BAR;
        PG8_STAGE(PG8_SB(1, 0), cB + kstep, voffB); PG8_STAGE(PG8_SA(1, 0), cA + kstep, voffA); PG8_STAGE(PG8_SB(1, 1), cB + hstep + kstep, voffB);
        PG8_WAIT_V(6); PG8_BAR;
    }
    for (;;) {
        const bool has_next = S.next(ui + 1, nxt);
        const char* nA = has_next ? (const char*)g.A + (size_t)nxt.pm * tstep + (size_t)nxt.k0t * kstep : cA; const char* nB = has_next ? (const char*)g.Bt + (size_t)nxt.pn * tstep + (size_t)nxt.k0t * kstep : cB;
        for (int t = 0; t < cnt; t += 2) {
            const bool last = (t == cnt - 2);
            const char* a1 = cA + (size_t)(t + 1) * kstep;
            const char* a2 = last ? nA : cA + (size_t)(t + 2) * kstep; const char* b2 = last ? nB : cB + (size_t)(t + 2) * kstep;
            const char* a3 = a2 + kstep; const char* b3 = b2 + kstep;
            if (last && has_next) S.a_ready(nxt);
            if constexpr (SP2) {
            PG8_LDB(B0, 0, 0); PG8_LDB(B1, 0, 1); PG8_SCHED; PG8_LDA(At, 0, 0); PG8_STAGE(PG8_SA(1, 1), a1 + hstep, voffA);
            PG8_WAIT_V(8); PG8_WAIT_L(0); PG8_BAR; PG8_MMA(0, 0, At, B0); PG8_MMA(0, 1, At, B1); PG8_BAR; PG8_SCHED;
            PG8_LDA(At, 0, 1); PG8_STAGE(PG8_SB(0, 0), b2, voffB); PG8_STAGE(PG8_SB(0, 1), b2 + hstep, voffB); PG8_STAGE(PG8_SA(0, 0), a2, voffA);
            PG8_WAIT_V(8); PG8_WAIT_L(0); PG8_BAR; PG8_MMA(1, 0, At, B0); PG8_MMA(1, 1, At, B1); PG8_BAR; PG8_SCHED;
            PG8_LDB(B0, 1, 0); PG8_LDB(B1, 1, 1); PG8_SCHED; PG8_LDA(At, 1, 0); PG8_STAGE(PG8_SA(0, 1), a2 + hstep, voffA);
            PG8_WAIT_V(8); PG8_WAIT_L(0); PG8_BAR; PG8_MMA(0, 0, At, B0); PG8_MMA(0, 1, At, B1); PG8_BAR; PG8_SCHED;
            PG8_LDA(At, 1, 1); PG8_STAGE(PG8_SB(1, 0), b3, voffB); PG8_STAGE(PG8_SB(1, 1), b3 + hstep, voffB); PG8_STAGE(PG8_SA(1, 0), a3, voffA);
            PG8_WAIT_V(8); PG8_WAIT_L(0); PG8_BAR; PG8_MMA(1, 0, At, B0); PG8_MMA(1, 1, At, B1); PG8_BAR; PG8_SCHED;
            } else {
            PG8_LDB(B0, 0, 0); PG8_SCHED; PG8_LDA(At, 0, 0); PG8_STAGE(PG8_SA(1, 1), a1 + hstep, voffA);
            PG8_WAIT_L(8); PG8_BAR; PG8_WAIT_L(0); PG8_MMA(0, 0, At, B0); PG8_BAR; PG8_SCHED;
            PG8_LDB(B1, 0, 1); PG8_STAGE(PG8_SB(0, 0), b2, voffB);
            PG8_BAR; PG8_WAIT_L(0); PG8_MMA(0, 1, At, B1); PG8_BAR;
            PG8_LDA(At, 0, 1); PG8_STAGE(PG8_SA(0, 0), a2, voffA);
            PG8_BAR; PG8_WAIT_L(0); PG8_MMA(1, 0, At, B0); PG8_BAR; PG8_SCHED;
            PG8_STAGE(PG8_SB(0, 1), b2 + hstep, voffB);
            PG8_WAIT_V(6); PG8_BAR; PG8_MMA(1, 1, At, B1); PG8_BAR;
            PG8_LDB(B0, 1, 0); PG8_SCHED; PG8_LDA(At, 1, 0); PG8_STAGE(PG8_SA(0, 1), a2 + hstep, voffA);
            PG8_WAIT_L(8); PG8_BAR; PG8_WAIT_L(0); PG8_MMA(0, 0, At, B0); PG8_BAR; PG8_SCHED;
            PG8_LDB(B1, 1, 1); PG8_STAGE(PG8_SB(1, 0), b3, voffB);
            PG8_BAR; PG8_WAIT_L(0); PG8_MMA(0, 1, At, B1); PG8_BAR;
            PG8_LDA(At, 1, 1); PG8_STAGE(PG8_SA(1, 0), a3, voffA);
            PG8_BAR; PG8_WAIT_L(0); PG8_MMA(1, 0, At, B0); PG8_BAR; PG8_SCHED;
            PG8_STAGE(PG8_SB(1, 1), b3 + hstep, voffB);
            PG8_WAIT_V(6); PG8_BAR; PG8_MMA(1, 1, At, B1); PG8_BAR;
            }
        }
        if constexpr (ALIGN_EPI) { if (wr == 0) PG8_BAR; }
        if constexpr (!Epi::AFTER_DRAIN) { E(acc, cur, wr, wc, fr, fq); S.done(cur); }
        if (!has_next) break;
#pragma unroll
        for (int a = 0; a < 2; ++a)
#pragma unroll
            for (int b = 0; b < 2; ++b)
#pragma unroll
                for (int m = 0; m < 4; ++m)
#pragma unroll
                    for (int n = 0; n < 2; ++n) acc[a][b][m][n] = (f32x4){0.f, 0.f, 0.f, 0.f};
        cur = nxt; cnt = cur.ntu; cA = nA; cB = nB; ++ui;
        if constexpr (ALIGN_EPI) { if (wr == 1) PG8_BAR; }
    }
    PG8_WAIT_V(0);
    if constexpr (!ALIGN_EPI) { if (wr == 0) PG8_BAR; }
    PG8_BAR;
    if constexpr (Epi::AFTER_DRAIN) { E.fused(acc, cur, wr, wc, fr, fq, lds, wid, lane); S.done(cur); }
#undef PG8_SA
#undef PG8_SB
#undef PG8_STAGE
#undef PG8_LDA
#undef PG8_LDB
#undef PG8_MMA
#undef PG8_WAIT_V
#undef PG8_WAIT_L
#undef PG8_BAR
#undef PG8_SCHED
}
}
struct Ctx {
    unsigned char* tab;
    __device__ __forceinline__ unsigned long long ldp(int i) const { const volatile unsigned* p = (const volatile unsigned*)(tab + 8 * i); unsigned lo = p[0], hi = p[1];
        lo = __builtin_amdgcn_readfirstlane(lo); hi = __builtin_amdgcn_readfirstlane(hi); return ((unsigned long long)hi << 32) | lo; }
    __device__ __forceinline__ const float* in(int i) const { return (const float*)(const __attribute__((address_space(1))) float*)ldp(i); }
    __device__ __forceinline__ float* out() const { return (float*)(__attribute__((address_space(1))) float*)ldp(25); }
    __device__ __forceinline__ unsigned char* ws() const { return (unsigned char*)(__attribute__((address_space(1))) unsigned char*)ldp(26); }
};
__device__ __forceinline__ float* ws_f(const Ctx& C, size_t off) { return (float*)(C.ws() + off); }
__device__ __forceinline__ bf16_t* ws_h(const Ctx& C, size_t off) { return (bf16_t*)(C.ws() + off); }

__device__ __forceinline__ void transpose_item(const float* W, int ldw, int K, bf16_t* WT, int k0, int n0, int drow0, float* scr, int lane) {
    float tv[32];
#pragma unroll
    for (int i = 0; i < 32; ++i) { const int kk = 2 * i + (lane >> 5); tv[i] = W[(size_t)(k0 + kk) * ldw + n0 + (lane & 31)]; }
#pragma unroll
    for (int i = 0; i < 32; ++i) { const int kk = 2 * i + (lane >> 5); scr[kk * 33 + (lane & 31)] = tv[i]; }
    __builtin_amdgcn_wave_barrier();
    const int c = lane & 7;
#pragma unroll
    for (int j = 0; j < 4; ++j) { const int n = (lane >> 3) + 8 * j; const float* s = scr + (8 * c) * 33 + n;
        u32x4 o; o.x = pk2(s[0 * 33], s[1 * 33]); o.y = pk2(s[2 * 33], s[3 * 33]); o.z = pk2(s[4 * 33], s[5 * 33]); o.w = pk2(s[6 * 33], s[7 * 33]);
        *(u32x4*)(WT + (size_t)(drow0 + n) * K + k0 + 8 * c) = o; }
    __builtin_amdgcn_wave_barrier();
}
__device__ __forceinline__ int map_gu(int n0) { return n0 < FF ? 256 * (n0 / 128) + (n0 % 128) : 256 * ((n0 - FF) / 128) + 128 + ((n0 - FF) % 128); }
__device__ __forceinline__ int map_ev(int n0) { return n0 < 512 ? 256 * (n0 / 128) + (n0 % 128) : (n0 < 1024 ? 256 * ((n0 - 512) / 128) + 128 + ((n0 - 512) % 128) : n0); }

__device__ __forceinline__ void block_transpose_item(const float* W, int ldw, int K, bf16_t* WT, int k0, int n0, int mapm, unsigned char* lds, int tid) {
    float* tile = (float*)lds;
    const int lane = tid & 63, wave = tid >> 6;
    f32x4 v[8];
#pragma unroll
    for (int rr = 0; rr < 8; ++rr) v[rr] = *(const f32x4*)(W + (size_t)(k0 + wave * 8 + rr) * ldw + n0 + 4 * lane);
    __syncthreads();
#pragma unroll
    for (int rr = 0; rr < 8; ++rr) *(f32x4*)(tile + (wave * 8 + rr) * 260 + 4 * lane) = v[rr];
    __syncthreads();
    const int n = tid & 255, half = tid >> 8; const float* tp = tile + (32 * half) * 260 + n;
    const int ng = n0 + n, n32 = ng & ~31; const int dn = (mapm == 1 ? map_gu(n32) : (mapm == 2 ? map_ev(n32) : n32)) + (ng & 31);
    bf16_t* op = WT + (size_t)dn * K + k0 + 32 * half;
#pragma unroll
    for (int q = 0; q < 4; ++q) { u32x4 o; o.x = pk2(tp[(8 * q + 0) * 260], tp[(8 * q + 1) * 260]); o.y = pk2(tp[(8 * q + 2) * 260], tp[(8 * q + 3) * 260]); o.z = pk2(tp[(8 * q + 4) * 260], tp[(8 * q + 5) * 260]); o.w = pk2(tp[(8 * q + 6) * 260], tp[(8 * q + 7) * 260]);
        *(u32x4*)(op + 8 * q) = o; }
}
constexpr int I_GU = 16 * 22, I_D = 44 * 4, I_EIN = 16 * 7, I_SQ = 16 * 4, I_OIN = 16 * 16;
__device__ __forceinline__ void conv_gu(const Ctx& C, unsigned char* wsb, int l, int f, int r, unsigned char* lds, int tid) { const int kb = r / 22, nb = r % 22;
    block_transpose_item(C.in(f ? 11 : 7) + (size_t)l * D * 2 * FF, 2 * FF, D, (bf16_t*)(wsb + WS_WGU) + (size_t)(l * 2 + f) * 5632 * D, 64 * kb, 256 * nb, 1, lds, tid); }
__device__ __forceinline__ void conv_d(const Ctx& C, unsigned char* wsb, int l, int f, int r, unsigned char* lds, int tid) { const int kb = r / 4, nb = r % 4;
    block_transpose_item(C.in(f ? 12 : 8) + (size_t)l * FF * D, D, FF, (bf16_t*)(wsb + WS_WD) + (size_t)(l * 2 + f) * D * FF, 64 * kb, 256 * nb, 0, lds, tid); }
__device__ __forceinline__ void convert_rest(const Ctx& C, unsigned char* lds, int vb, int VG) {
    const int tid = tid_opaque();
    unsigned char* wsb = C.ws();
    constexpr int NITEMS = 3 * I_GU + 3 * I_D + I_EIN + I_SQ + I_OIN + I_SQ;
    for (int it = vb; it < NITEMS; it += VG) {
        int r = it;
        if (r < 3 * I_GU) { const int mi = r / I_GU + 1; conv_gu(C, wsb, mi >> 1, mi & 1, r - (mi - 1) * I_GU, lds, tid); continue; }
        r -= 3 * I_GU;
        if (r < 3 * I_D) { const int mi = r / I_D + 1; conv_d(C, wsb, mi >> 1, mi & 1, r - (mi - 1) * I_D, lds, tid); continue; }
        r -= 3 * I_D;
        if (r < I_EIN) { const int kb = r / 7, nb = r % 7; block_transpose_item(C.in(13), EVIN, D, (bf16_t*)(wsb + WS_WEIN), 64 * kb, 256 * nb, 2, lds, tid); continue; }
        r -= I_EIN;
        if (r < I_SQ) { const int kb = r / 4, nb = r % 4; block_transpose_item(C.in(19), D, D, (bf16_t*)(wsb + WS_WEOUT), 64 * kb, 256 * nb, 0, lds, tid); continue; }
        r -= I_SQ;
        if (r < I_OIN) { const int kb = r / 16, nb = r % 16; block_transpose_item(C.in(20), ODIN, D, (bf16_t*)(wsb + WS_WOIN), 64 * kb, 256 * nb, 0, lds, tid); continue; }
        r -= I_OIN;
        { const int kb = r / 4, nb = r % 4; block_transpose_item(C.in(23), D, D, (bf16_t*)(wsb + WS_WOOUT), 64 * kb, 256 * nb, 0, lds, tid); }
    }
    __syncthreads();
}

__device__ __forceinline__ void phase_p0(const Ctx& C, unsigned char* lds, int G) {
    const int tid = tid_opaque(), lane = tid & 63, wave = tid >> 6;
    unsigned char* wsb = C.ws();
    float* sc = (float*)(lds + 81920);
    { const float* cc = C.in(1); const float* cx = C.in(3);
#pragma unroll
      for (int it = 0; it < 10; ++it) { const int i = tid + 512 * it; const int ci = i >> 10, k = i & 1023; const float v = ci < 4 ? cc[ci * D + k] : cx[k]; sc[i] = siluf_(v); } }
    __syncthreads();
    const int gw = blockIdx.x * 8 + wave, NGW = G * 8;
    float* MODS = (float*)(wsb + WS_MODS);
    const float* modw = C.in(4); const float* modb = C.in(5);
    for (int item = wave * G + (int)blockIdx.x; item < 2 * 36 * 16; item += NGW) {
        const int l = item / 576, r = item % 576, ch = r >> 4, ksl = r & 15, j0 = ch * 256 + 4 * lane, k0 = ksl * 64;
        const float* w = modw + (size_t)l * D * NMODC + (size_t)k0 * NMODC + j0;
        f32x4 a0 = {0.f, 0.f, 0.f, 0.f}, a1 = a0, a2 = a0, a3 = a0, a4 = a0;
#pragma unroll 16
        for (int kk = 0; kk < 64; ++kk) { const f32x4 wv = *(const f32x4*)(w + (size_t)kk * NMODC); const int k = k0 + kk;
            a0 += wv * sc[k]; a1 += wv * sc[D + k]; a2 += wv * sc[2 * D + k]; a3 += wv * sc[3 * D + k]; a4 += wv * sc[4 * D + k]; }
        if (ksl == 0) { const f32x4 bv = *(const f32x4*)(modb + l * NMODC + j0); a0 += bv; a1 += bv; a2 += bv; a3 += bv; a4 += bv; }
        float* mp = MODS + (size_t)(l * 5) * NMODC + j0;
#pragma unroll
        for (int e = 0; e < 4; ++e) { atomicAdd(mp + e, a0[e]); atomicAdd(mp + NMODC + e, a1[e]); atomicAdd(mp + 2 * NMODC + e, a2[e]); atomicAdd(mp + 3 * NMODC + e, a3[e]); atomicAdd(mp + 4 * NMODC + e, a4[e]); }
    }
    if (blockIdx.x == 0) { for (int i = tid; i < 1024; i += 512) { const int p = i >> 4, f = i & 15; const float inv = exp2f(-(float)f * (13.287712379549449f / 16.0f)); const float rev = (float)p * inv * 0.15915494309189535f;
            float* rp = (float*)(wsb + WS_ROPE); rp[i] = __builtin_amdgcn_cosf(rev); rp[1024 + i] = __builtin_amdgcn_sinf(rev); } }
    for (int it = blockIdx.x; it < I_GU + I_D; it += G) { if (it < I_GU) conv_gu(C, wsb, 0, 0, it, lds, tid); else conv_d(C, wsb, 0, 0, it - I_GU, lds, tid); }
    __syncthreads();
}

__device__ __forceinline__ void phase_p0b(const Ctx& C, unsigned char* lds, int G) {
    const int tid = tid_opaque(), lane = tid & 63, wave = tid >> 6;
    const int gw = blockIdx.x * 8 + wave, NGW = G * 8;
    unsigned char* wsb = C.ws();
    const float* MODS = (const float*)(wsb + WS_MODS);
    float* sh = (float*)lds;
#pragma unroll 20
    for (int it = 0; it < 60; ++it) { const int i = tid + 512 * it; const int inst = i / (5 * D), r = i % (5 * D), ci = r >> 10, kk = r & 1023; sh[i] = MODS[(size_t)((inst / 3) * 5 + ci) * NMODC + (3 * (inst % 3)) * D + kk]; }
    float* RS = (float*)(wsb + WS_RS); bf16_t* XN = (bf16_t*)(wsb + WS_XN);
    const float* xin = C.in(0); const float* cin = C.in(2); const float* g = C.in(6);
    for (int r0 = 2 * gw; r0 < M; r0 += 2 * NGW) {
        f32x4 v[2][4]; float ss[2];
#pragma unroll
        for (int q = 0; q < 2; ++q) { const int r = r0 + q; const float* xr = r < ML ? xin + (size_t)r * D : cin + (size_t)(r - ML) * D;
#pragma unroll
            for (int j = 0; j < 4; ++j) v[q][j] = *(const f32x4*)(xr + 4 * lane + 256 * j); }
#pragma unroll
        for (int q = 0; q < 2; ++q) { float t = 0.f;
#pragma unroll
            for (int j = 0; j < 4; ++j) t += (v[q][j][0] * v[q][j][0] + v[q][j][1] * v[q][j][1]) + (v[q][j][2] * v[q][j][2] + v[q][j][3] * v[q][j][3]);
            ss[q] = wave_sum(t); }
        const int ci = r0 < ML ? r0 >> 12 : 4; const float* scl = MODS + (size_t)ci * NMODC + D;
#pragma unroll
        for (int q = 0; q < 2; ++q) { const int r = r0 + q; if (lane == 0) RS[r] = ss[q];
#pragma unroll
            for (int j = 0; j < 4; ++j) { const int col = 4 * lane + 256 * j; const f32x4 y = v[q][j] * (*(const f32x4*)(g + col) * (*(const f32x4*)(scl + col) + 1.0f));
                u32x2 w; w.x = pk2(y[0], y[1]); w.y = pk2(y[2], y[3]); *(u32x2*)(XN + (size_t)r * D + col) = w; } }
    }
    __syncthreads();
    float* SB = (float*)(wsb + WS_SB);
    constexpr int C_GU = 88, C_EV = 28, C_OD = 64;
    constexpr int NCH = 4 * C_GU + C_EV + C_OD;
    for (int item = gw; item < NCH * 16; item += NGW) {
        const int ksl = item & 15; int ch = item >> 4; int inst, N, ldw, mapm; const float* W;
        if (ch < 4 * C_GU) { const int mi = ch / C_GU; ch -= mi * C_GU; const int l = mi >> 1, f = mi & 1; inst = l * 3 + 2 * f; N = 5632; ldw = 5632; mapm = 1; W = C.in(f ? 11 : 7) + (size_t)l * D * 5632; }
        else if (ch < 4 * C_GU + C_EV) { ch -= 4 * C_GU; inst = 1; N = EVIN; ldw = EVIN; mapm = 2; W = C.in(13); }
        else { ch -= 4 * C_GU + C_EV; inst = 4; N = ODN; ldw = ODIN; mapm = 0; W = C.in(20); }
        const int n = ch * 64 + lane, k0 = ksl * 64;
        const float* wp = W + (size_t)k0 * ldw + n; const float* shp = sh + inst * 5 * D + k0;
        float a0 = 0.f, a1 = 0.f, a2 = 0.f, a3 = 0.f, a4 = 0.f;
#pragma unroll 32
        for (int kk = 0; kk < 64; ++kk) { const float wv = wp[(size_t)kk * ldw]; a0 += shp[kk] * wv; a1 += shp[D + kk] * wv; a2 += shp[2 * D + kk] * wv; a3 += shp[3 * D + kk] * wv; a4 += shp[4 * D + kk] * wv; }
        const int n32 = n & ~31; const int dn = (mapm == 1 ? map_gu(n32) : (mapm == 2 ? map_ev(n32) : n32)) + (n & 31);
        float* sp = SB + (size_t)(inst * 5) * 5632 + dn;
        atomicAdd(sp, a0); atomicAdd(sp + 5632, a1); atomicAdd(sp + 2 * 5632, a2); atomicAdd(sp + 3 * 5632, a3); atomicAdd(sp + 4 * 5632, a4);
    }
    __syncthreads();
    convert_rest(C, lds, blockIdx.x, G);
}

__device__ __forceinline__ void phase_gates(const Ctx& C, unsigned char* lds, int G) {
    const int tid = tid_opaque(), lane = tid & 63, wave = tid >> 6, m16 = lane & 15, kg = lane >> 4;
    float* wgt = (float*)lds;
    { const float* wsrc = C.in(20);
#pragma unroll
      for (int it = 0; it < 32; ++it) { const int i = tid + 512 * it; const int k = i >> 4, j = i & 15; wgt[j * 1028 + k] = wsrc[(size_t)k * ODIN + ODN + j]; } }
    float* gst = (float*)(lds + 66048);
    float* sht = (float*)(lds + 66048 + 20480);
    { const float* MODS1 = ws_f(C, WS_MODS) + (size_t)5 * NMODC; const float* gp = C.in(9) + D;
#pragma unroll
      for (int it = 0; it < 10; ++it) { const int i = tid + 512 * it, ci = i >> 10, k = i & 1023; gst[i] = gp[k] * (MODS1[(size_t)ci * NMODC + 4 * D + k] + 1.0f); sht[i] = MODS1[(size_t)ci * NMODC + 3 * D + k]; } }
    __syncthreads();
    const int nskip = (G > 64 && 800 % G != 0) ? (800 % G) : 0;
    const int gw = ((int)blockIdx.x - nskip) * 8 + wave, NGW = (G - nskip) * 8;
    const float* MODS = ws_f(C, WS_MODS) + (size_t)5 * NMODC;
    const float* RS = ws_f(C, WS_RS) + (size_t)4 * M;
    float* GT = ws_f(C, WS_GATES);
    const float* xl = C.out(); const float* xc = ws_f(C, WS_XC); const float* g = C.in(9) + D; const float* bg = C.in(21);
    for (int rg = gw < 0 ? M / 16 : gw; rg < M / 16; rg += NGW) {
        const int r = rg * 16 + m16;
        const float* xr = r < ML ? xl + (size_t)r * D : xc + (size_t)(r - ML) * D;
        const int ci = r < ML ? r >> 12 : 4;
        const float rstd = __builtin_amdgcn_rsqf(RS[r] * (1.0f / 1024.0f) + EPS);
        const float* shf = sht + ci * D; const float* gsp = gst + ci * D;
        f32x4 acc = {0.f, 0.f, 0.f, 0.f};
#pragma unroll 16
        for (int k0 = 0; k0 < D; k0 += 16) { const int k = k0 + 4 * kg;
            const f32x4 hv = *(const f32x4*)(xr + k) * rstd * *(const f32x4*)(gsp + k) + *(const f32x4*)(shf + k);
            const f32x4 wv = *(const f32x4*)(wgt + m16 * 1028 + k);
            acc = __builtin_amdgcn_mfma_f32_16x16x4f32(hv[0], wv[0], acc, 0, 0, 0); acc = __builtin_amdgcn_mfma_f32_16x16x4f32(hv[1], wv[1], acc, 0, 0, 0);
            acc = __builtin_amdgcn_mfma_f32_16x16x4f32(hv[2], wv[2], acc, 0, 0, 0); acc = __builtin_amdgcn_mfma_f32_16x16x4f32(hv[3], wv[3], acc, 0, 0, 0); }
        const float bgv = bg[m16];
#pragma unroll
        for (int j = 0; j < 4; ++j) GT[(size_t)(rg * 16 + 4 * kg + j) * 16 + m16] = acc[j] + bgv;
    }
    __syncthreads();
}

template <int NSL> __device__ __forceinline__ void phase_ctx_fin(const Ctx& C, int G, float gcoef, const float* basec, size_t gate_off, const float* ng, size_t nscale_off, size_t rs_off) {
    const int tid = tid_opaque(), lane = tid & 63, wave = tid >> 6;
    const int gw = blockIdx.x * 8 + wave, NGW = G * 8;
    unsigned char* wsb = C.ws();
    const float* part = (const float*)(wsb + WS_PART); float* XCp = (float*)(wsb + WS_XC); bf16_t* XNp = (bf16_t*)(wsb + WS_XN); float* RSp = (float*)(wsb + rs_off);
    const float* gate = (const float*)(wsb + gate_off) + 4 * NMODC; const float* nsc = (const float*)(wsb + nscale_off) + 4 * NMODC;
    for (int r = gw; r < MC; r += NGW) {
        float ss = 0.f;
#pragma unroll
        for (int j = 0; j < 4; ++j) { const int col = 4 * lane + 256 * j; f32x4 a = {0.f, 0.f, 0.f, 0.f};
#pragma unroll
            for (int sl = 0; sl < NSL; ++sl) a += *(const f32x4*)(part + ((size_t)sl * MC + r) * D + col);
            const f32x4 x = *(const f32x4*)(basec + (size_t)r * D + col) + *(const f32x4*)(gate + col) * gcoef * a; *(f32x4*)(XCp + (size_t)r * D + col) = x;
            ss += (x[0] * x[0] + x[1] * x[1]) + (x[2] * x[2] + x[3] * x[3]);
            const f32x4 y = x * (*(const f32x4*)(ng + col) * (*(const f32x4*)(nsc + col) + 1.0f));
            u32x2 w; w.x = pk2(y[0], y[1]); w.y = pk2(y[2], y[3]); *(u32x2*)(XNp + (size_t)(ML + r) * D + col) = w; }
        ss = wave_sum(ss);
        if (lane == 0) RSp[ML + r] = ss;
    }
}
__device__ __forceinline__ void phase_hn(const Ctx& C, int G) {
    const int tid = tid_opaque(), lane = tid & 63, wave = tid >> 6;
    const int gw = blockIdx.x * 8 + wave, NGW = G * 8;
    const bf16_t* HF = ws_h(C, WS_HF); const bf16_t* HB = ws_h(C, WS_HB); bf16_t* HN = ws_h(C, WS_HN); const float* ngp = C.in(22);
    for (int r0 = 2 * gw; r0 < ML; r0 += 2 * NGW) {
        u32x2 a[2][4], b[2][4];
#pragma unroll
        for (int q = 0; q < 2; ++q)
#pragma unroll
            for (int hd = 0; hd < 4; ++hd) { const size_t o = (size_t)(r0 + q) * D + hd * 256 + 4 * lane; a[q][hd] = *(const u32x2*)(HF + o); b[q][hd] = *(const u32x2*)(HB + o); }
#pragma unroll
        for (int q = 0; q < 2; ++q)
#pragma unroll
            for (int hd = 0; hd < 4; ++hd) { const int col = hd * 256 + 4 * lane;
                f32x4 s = {bflo(a[q][hd].x) + bflo(b[q][hd].x), bfhi(a[q][hd].x) + bfhi(b[q][hd].x), bflo(a[q][hd].y) + bflo(b[q][hd].y), bfhi(a[q][hd].y) + bfhi(b[q][hd].y)};
                const float ss = wave_sum((s[0] * s[0] + s[1] * s[1]) + (s[2] * s[2] + s[3] * s[3]));
                const float rr = __builtin_amdgcn_rsqf(ss * (1.0f / 256.0f) + EPS);
                const f32x4 y = s * rr * *(const f32x4*)(ngp + col);
                u32x2 w; w.x = pk2(y[0], y[1]); w.y = pk2(y[2], y[3]); *(u32x2*)(HN + (size_t)(r0 + q) * D + col) = w; }
    }
}
__device__ __forceinline__ void phase_final(const Ctx& C, int G) {
    const int tid = tid_opaque(), lane = tid & 63, wave = tid >> 6;
    const int gw = blockIdx.x * 8 + wave, NGW = G * 8;
    const float* RS = ws_f(C, WS_RS) + (size_t)6 * M; float* xo = C.out(); const float* fn = C.in(24);
    for (int r0 = 2 * gw; r0 < ML; r0 += 2 * NGW) {
        f32x4 v[2][4]; float rstd[2];
#pragma unroll
        for (int q = 0; q < 2; ++q) { rstd[q] = __builtin_amdgcn_rsqf(RS[r0 + q] * (1.0f / 1024.0f) + EPS);
#pragma unroll
            for (int j = 0; j < 4; ++j) v[q][j] = *(const f32x4*)(xo + (size_t)(r0 + q) * D + 4 * lane + 256 * j); }
#pragma unroll
        for (int q = 0; q < 2; ++q)
#pragma unroll
            for (int j = 0; j < 4; ++j) { const int col = 4 * lane + 256 * j; *(f32x4*)(xo + (size_t)(r0 + q) * D + col) = v[q][j] * rstd[q] * *(const f32x4*)(fn + col); }
    }
}
__device__ __forceinline__ bf16x8 ld_bf16x8(const void* p) { return *(const bf16x8*)p; }
__device__ __forceinline__ void attn_unit(const Ctx& C, unsigned char* lds, int qrow0, int kvh, int hp, int nch, int kr0, int kr1, int kr2, int kr3, int kr4, int md0, int md1, int md2) {
    const int tid = tid_opaque(), lane = tid & 63, wave = tid >> 6, fr = lane & 15, fq = lane >> 4;
    const bf16_t* Q = ws_h(C, WS_Q); const bf16_t* KV = ws_h(C, WS_KV); bf16_t* MIXA = ws_h(C, WS_MIXA_E);
    unsigned char* Ks = lds;
    unsigned char* Vt = lds + 18432;
    const int g = wave >> 2, quarter = wave & 3, head = kvh * 4 + hp * 2 + g;
    bf16x8 qf[2][2];
#pragma unroll
    for (int qt = 0; qt < 2; ++qt)
#pragma unroll
        for (int ks = 0; ks < 2; ++ks) qf[qt][ks] = ld_bf16x8(Q + (size_t)(qrow0 + quarter * 32 + 16 * qt + fr) * 512 + head * 64 + 32 * ks + 8 * fq);
    const float sink2 = C.in(18)[head] * LOG2E;
    float mrun[2], lrun[2]; f32x4 O[2][4];
#pragma unroll
    for (int qt = 0; qt < 2; ++qt) { mrun[qt] = sink2; lrun[qt] = 1.f;
#pragma unroll
        for (int dt = 0; dt < 4; ++dt) O[qt][dt] = (f32x4){0.f, 0.f, 0.f, 0.f}; }
    u32x4 kreg[2], vreg[2];
#define ATT_FETCH(krow_) do { _Pragma("unroll") for (int i = 0; i < 2; ++i) { const int p = tid + 512 * i; \
            kreg[i] = *(const u32x4*)(KV + (size_t)((krow_) + (p >> 3)) * 256 + kvh * 64 + 8 * (p & 7)); \
            vreg[i] = *(const u32x4*)(KV + (size_t)((krow_) + (p & 127)) * 256 + 128 + kvh * 64 + 8 * (p >> 7)); } } while (0)
    ATT_FETCH(kr0);
    for (int c = 0; c < nch; ++c) {
        const int mode = c == 0 ? md0 : (c == 1 ? md1 : (c == 2 ? md2 : 0));
        __syncthreads();
#pragma unroll
        for (int i = 0; i < 2; ++i) { const int p = tid + 512 * i;
            *(u32x4*)(Ks + (p >> 3) * 144 + (p & 7) * 16) = kreg[i];
            const u32x4 vv = vreg[i];
            bf16_t* vt = (bf16_t*)(Vt + (8 * (p >> 7)) * 272) + (p & 127);
            vt[0 * 136] = (bf16_t)(vv.x & 0xffff); vt[1 * 136] = (bf16_t)(vv.x >> 16); vt[2 * 136] = (bf16_t)(vv.y & 0xffff); vt[3 * 136] = (bf16_t)(vv.y >> 16);
            vt[4 * 136] = (bf16_t)(vv.z & 0xffff); vt[5 * 136] = (bf16_t)(vv.z >> 16); vt[6 * 136] = (bf16_t)(vv.w & 0xffff); vt[7 * 136] = (bf16_t)(vv.w >> 16); }
        __syncthreads();
        if (c + 1 < nch) { const int krn = c == 0 ? kr1 : (c == 1 ? kr2 : (c == 2 ? kr3 : kr4)); ATT_FETCH(krn); }
        const int mlo = mode == 1 ? 0 : -1000, mhi = mode == 2 ? 0 : 1000;
#pragma unroll
        for (int qt = 0; qt < 2; ++qt) {
            f32x4 st[8];
#pragma unroll
            for (int kt = 0; kt < 8; ++kt) { st[kt] = (f32x4){0.f, 0.f, 0.f, 0.f};
#pragma unroll
                for (int ks = 0; ks < 2; ++ks) st[kt] = __builtin_amdgcn_mfma_f32_16x16x32_bf16(ld_bf16x8(Ks + (16 * kt + fr) * 144 + (32 * ks + 8 * fq) * 2), qf[qt][ks], st[kt], 0, 0, 0); }
            const int qoff = quarter * 32 + 16 * qt + fr;
            if (mode != 0) {
#pragma unroll
                for (int kt = 0; kt < 8; ++kt)
#pragma unroll
                    for (int j = 0; j < 4; ++j) { const int rel = 16 * kt + 4 * fq + j - qoff; st[kt][j] = (rel < mlo || rel > mhi) ? -INFINITY : st[kt][j]; } }
            float mx = -INFINITY;
#pragma unroll
            for (int kt = 0; kt < 8; kt += 2) {
                const float a_ = __builtin_fmaxf(__builtin_fmaxf(st[kt][0], st[kt][1]), st[kt][2]), b_ = __builtin_fmaxf(__builtin_fmaxf(st[kt][3], st[kt + 1][0]), st[kt + 1][1]);
                const float c_ = __builtin_fmaxf(__builtin_fmaxf(st[kt + 1][2], st[kt + 1][3]), mx); mx = __builtin_fmaxf(__builtin_fmaxf(a_, b_), c_); }
            mx = fmaxf(mx, __shfl_xor(mx, 16)); mx = fmaxf(mx, __shfl_xor(mx, 32));
            const float mnew = fmaxf(mrun[qt], mx), alpha = exp2f(mrun[qt] - mnew);
            float rsum = 0.f;
#pragma unroll
            for (int kt = 0; kt < 8; ++kt)
#pragma unroll
                for (int j = 0; j < 4; ++j) { st[kt][j] = __expf((st[kt][j] - mnew) * 0.6931471805599453f); rsum += st[kt][j]; }
            rsum += __shfl_xor(rsum, 16); rsum += __shfl_xor(rsum, 32);
            lrun[qt] = lrun[qt] * alpha + rsum; mrun[qt] = mnew;
#pragma unroll
            for (int dt = 0; dt < 4; ++dt) O[qt][dt] *= alpha;
#pragma unroll
            for (int kk = 0; kk < 4; ++kk) {
                u32x4 pw; pw.x = pk2(st[2 * kk][0], st[2 * kk][1]); pw.y = pk2(st[2 * kk][2], st[2 * kk][3]); pw.z = pk2(st[2 * kk + 1][0], st[2 * kk + 1][1]); pw.w = pk2(st[2 * kk + 1][2], st[2 * kk + 1][3]);
                const bf16x8 pb = __builtin_bit_cast(bf16x8, pw);
#pragma unroll
                for (int dt = 0; dt < 4; ++dt) {
                    const unsigned char* vp = Vt + (16 * dt + fr) * 272 + (32 * kk + 4 * fq) * 2;
                    const u32x2 lo = *(const u32x2*)vp, hi = *(const u32x2*)(vp + 32);
                    u32x4 vw; vw.x = lo.x; vw.y = lo.y; vw.z = hi.x; vw.w = hi.y;
                    O[qt][dt] = __builtin_amdgcn_mfma_f32_16x16x32_bf16(__builtin_bit_cast(bf16x8, vw), pb, O[qt][dt], 0, 0, 0);
                }
            }
            asm volatile("" ::: "memory"); __builtin_amdgcn_sched_barrier(0);
        }
    }
#pragma unroll
    for (int qt = 0; qt < 2; ++qt) { const float inv = 1.0f / lrun[qt]; const int row = qrow0 + quarter * 32 + 16 * qt + fr;
#pragma unroll
        for (int dt = 0; dt < 4; ++dt) { const f32x4 o = O[qt][dt] * inv; u32x2 w; w.x = pk2(o[0], o[1]); w.y = pk2(o[2], o[3]);
            *(u32x2*)(MIXA + (size_t)row * D + 512 + head * 64 + 16 * dt + 4 * fq) = w; } }
#undef ATT_FETCH
}

__device__ __forceinline__ void conv_unit(const Ctx& C, unsigned char* lds, int srow0, int slen, int t0) {
    const int tid = tid_opaque(), lane = tid & 63, wave = tid >> 6, c = tid;
    unsigned char* wsb = C.ws();
    const bf16_t* U = (const bf16_t*)(wsb + WS_U); bf16_t* MIXA = (bf16_t*)(wsb + WS_MIXA_E);
    float* yt = (float*)lds;
    const int cp = tid & 255, hp = tid >> 8;
    f32x2 w2[31];
    { const float* cw = C.in(14);
#pragma unroll
      for (int j = 0; j < 31; ++j) w2[j] = *(const f32x2*)(cw + j * 512 + 2 * cp); }
    const f32x2 bias2 = *(const f32x2*)(C.in(15) + 2 * cp);
    f32x2 win[32];
#pragma unroll
    for (int i = 0; i < 32; ++i) win[i] = (f32x2){0.f, 0.f};
#pragma unroll 1
    for (int blk = 0; blk < 2; ++blk) {
        unsigned nw[32];
#pragma unroll
        for (int i = 0; i < 32; ++i) { const int il = 32 * blk + i, t = t0 - 15 + 32 * hp + il; nw[i] = (il < 62 && t >= 0 && t < slen) ? *(const unsigned*)(U + (size_t)(srow0 + t) * 512 + 2 * cp) : 0u; }
#pragma unroll
        for (int i = 0; i < 32; ++i) { win[i] = (f32x2){bflo(nw[i]), bfhi(nw[i])}; const int ol = 32 * blk + i - 30;
            if (ol >= 0 && ol < 32) { f32x2 a2 = bias2;
#pragma unroll
                for (int j = 0; j < 31; ++j) a2 += w2[j] * win[(i + 2 + j) & 31];
                *(f32x2*)(yt + (32 * hp + ol) * 512 + 2 * cp) = a2; } }
    }
    __syncthreads();
    { const float* lgp = C.in(16); const float* lbp = C.in(17);
      const f32x4 g0 = *(const f32x4*)(lgp + 4 * lane), g1 = *(const f32x4*)(lgp + 256 + 4 * lane), b0 = *(const f32x4*)(lbp + 4 * lane), b1 = *(const f32x4*)(lbp + 256 + 4 * lane);
#pragma unroll 2
      for (int r = 0; r < 8; ++r) { const int o = wave * 8 + r;
          const f32x4 y0 = *(const f32x4*)(yt + o * 512 + 4 * lane), y1 = *(const f32x4*)(yt + o * 512 + 256 + 4 * lane);
          const float s1 = wave_sum((y0[0] + y0[1]) + (y0[2] + y0[3]) + (y1[0] + y1[1]) + (y1[2] + y1[3]));
          const float mu = s1 * (1.0f / 512.0f); const f32x4 d0 = y0 - mu, d1 = y1 - mu;
          const float s2 = wave_sum((d0[0] * d0[0] + d0[1] * d0[1]) + (d0[2] * d0[2] + d0[3] * d0[3]) + (d1[0] * d1[0] + d1[1] * d1[1]) + (d1[2] * d1[2] + d1[3] * d1[3]));
          const float rstd = __builtin_amdgcn_rsqf(s2 * (1.0f / 512.0f) + EPS);
          const f32x4 v0 = d0 * rstd * g0 + b0, v1 = d1 * rstd * g1 + b1;
          bf16_t* op = MIXA + (size_t)(srow0 + t0 + o) * D;
          u32x2 wv; wv.x = pk2(siluf_(v0[0]), siluf_(v0[1])); wv.y = pk2(siluf_(v0[2]), siluf_(v0[3])); *(u32x2*)(op + 4 * lane) = wv;
          wv.x = pk2(siluf_(v1[0]), siluf_(v1[1])); wv.y = pk2(siluf_(v1[2]), siluf_(v1[3])); *(u32x2*)(op + 256 + 4 * lane) = wv; } }
}

__device__ __forceinline__ void phase_even_mix(const Ctx& C, unsigned char* lds, int G) {
    unsigned* qctr = (unsigned*)(C.ws() + WS_QCTR);
    volatile unsigned* qslot = (volatile unsigned*)(lds + LDS_BYTES - 384);
    for (;;) {
        __syncthreads();
        if (threadIdx.x == 0) *qslot = atomicAdd(qctr, 1u);
        __syncthreads();
        const int u = (int)*qslot;
        if (u >= 816) break;
        if (u < 544) {
            int qrow0, kvh, hp, nch, kr0, kr1, kr2 = 0, kr3 = 0, kr4 = 0, md0 = 0, md1 = 0, md2 = 0;
            if (u < 512) { const int b = u >> 7, qb = (u >> 2) & 31; kvh = (u >> 1) & 1; hp = u & 1; const int base = b * SEQ, c0 = ML + b * CTXL; qrow0 = base + qb * 128;
                if (qb == 0) { nch = 4; kr0 = base; kr1 = base + 128; kr2 = c0; kr3 = c0 + 128; md1 = 2; }
                else if (qb == 31) { nch = 4; kr0 = base + 30 * 128; kr1 = base + 31 * 128; kr2 = c0; kr3 = c0 + 128; md0 = 1; }
                else { nch = 5; kr0 = base + (qb - 1) * 128; kr1 = base + qb * 128; kr2 = base + (qb + 1) * 128; kr3 = c0; kr4 = c0 + 128; md0 = 1; md2 = 2; }
            } else { const int e = u - 512, b = e >> 3, hf = (e >> 1) & 1; kvh = (e >> 2) & 1; hp = e & 1; const int c0 = ML + b * CTXL; qrow0 = c0 + hf * 128; nch = 2; kr0 = c0; kr1 = c0 + 128; }
            attn_unit(C, lds, qrow0, kvh, hp, nch, kr0, kr1, kr2, kr3, kr4, md0, md1, md2);
        } else { const int e = u - 544; int s0, sl, t0;
            if (e < 256) { s0 = (e >> 6) * SEQ; sl = SEQ; t0 = (e & 63) * 64; } else { const int f = e - 256; s0 = ML + (f >> 2) * CTXL; sl = CTXL; t0 = (f & 3) * 64; }
            conv_unit(C, lds, s0, sl, t0);
            __syncthreads();
        }
    }
}
typedef short v4i16_t __attribute__((ext_vector_type(4)));
__device__ __forceinline__ s16x4 lds_tr16(const unsigned char* p) { return __builtin_bit_cast(s16x4, __builtin_amdgcn_ds_read_tr16_b64_v4i16((__attribute__((address_space(3))) v4i16_t*)p)); }
__device__ __forceinline__ void phase_scan(const Ctx& C, unsigned char* lds, int G) {
    const int tid = tid_opaque(), lane = tid & 63, wave = tid >> 6, fr = lane & 15, fq = lane >> 4;
    unsigned char* wsb = C.ws();
    const bf16_t* QB = (const bf16_t*)(wsb + WS_QKV); const bf16_t* KB = QB + (size_t)M * D; const bf16_t* VB = QB + (size_t)2 * M * D;
    const float* GT = (const float*)(wsb + WS_GATES);
    unsigned char* KT = lds;
    unsigned char* VT = lds + 69632;
    unsigned char* VW = lds + 78336;
    unsigned char* CB = lds + 91392;
    float* SC = (float*)(lds + 116736);
    const int qt = wave < 4 ? wave : 11 - wave;
    for (int unit = blockIdx.x; unit < 256; unit += G) {
        const int b = unit >> 6, h = (unit >> 4) & 3, dir = (unit >> 3) & 1, vs = unit & 7;
        bf16_t* HO = (bf16_t*)(wsb + (dir ? WS_HB : WS_HF));
        __syncthreads();
        for (int i = tid; i < (13056 + 25344) / 4; i += 512) ((unsigned*)VW)[i] = 0u;
        f32x4 Cacc[3][2];
#pragma unroll
        for (int a = 0; a < 3; ++a)
#pragma unroll
            for (int bb = 0; bb < 2; ++bb) Cacc[a][bb] = (f32x4){0.f, 0.f, 0.f, 0.f};
        float mstate = 0.f;
        u32x4 kreg[8]; u32x4 vreg; bf16x8 qn[8];
        float gi0 = 0.f, gf0 = 0.f, gi1 = 0.f, gf1 = 0.f;
#define STEP_R0(s) ((s) < 2 ? ML + b * CTXL + (dir ? 1 - (s) : (s)) * 128 : b * SEQ + (dir ? 33 - (s) : (s) - 2) * 128)
#define SROWX(r0_, l) ((r0_) + (dir ? 127 - (l) : (l)))
#define SCAN_FETCH(s) do { const int r0f = STEP_R0(s); \
            _Pragma("unroll") for (int i = 0; i < 8; ++i) { const int p = tid + 512 * i, l = p >> 5, c16 = p & 31; kreg[i] = *(const u32x4*)(KB + (size_t)SROWX(r0f, l) * D + h * 256 + 8 * c16); } \
            { const int l = tid & 127, c = tid >> 7; vreg = *(const u32x4*)(VB + (size_t)SROWX(r0f, l) * D + h * 256 + vs * 32 + 8 * c); } \
            if (wave == 0) { const int l0 = 2 * lane, l1 = l0 + 1; const float* g0p = GT + (size_t)SROWX(r0f, l0) * 16 + dir * 8 + h; const float* g1p = GT + (size_t)SROWX(r0f, l1) * 16 + dir * 8 + h; \
                gi0 = g0p[0]; gf0 = g0p[4]; gi1 = g1p[0]; gf1 = g1p[4]; } } while (0)
#define SCAN_FETCHQ(s) do { if ((s) >= 2) { const int r0f = STEP_R0(s); _Pragma("unroll") for (int ks = 0; ks < 8; ++ks) qn[ks] = ld_bf16x8(QB + (size_t)SROWX(r0f, 16 * qt + fr) * D + h * 256 + 32 * ks + 8 * fq); } } while (0)
#define SCAN_SCALARS(dst) do { float* scw = (dst); const int l0 = 2 * lane, l1 = l0 + 1; \
            const float lf0 = fminf(gf0, 0.f) - __logf(1.f + __expf(-fabsf(gf0))), lf1 = fminf(gf1, 0.f) - __logf(1.f + __expf(-fabsf(gf1))); \
            float S = lf0 + lf1; \
            _Pragma("unroll") for (int o = 1; o < 64; o <<= 1) { const float t_ = __shfl_up(S, o); if (lane >= o) S += t_; } \
            const float b1 = S, b0 = S - lf1, a0 = gi0 - b0, a1 = gi1 - b1; \
            float P = fmaxf(a0, a1); \
            _Pragma("unroll") for (int o = 1; o < 64; o <<= 1) { const float t_ = __shfl_up(P, o); if (lane >= o) P = fmaxf(P, t_); } \
            float ex = __shfl_up(P, 1); if (lane == 0) ex = -INFINITY; \
            const float pm0 = fmaxf(ex, a0), pm1 = P, PM = __shfl(P, 63), bend = __shfl(S, 63), mx = fmaxf(mstate, PM); \
            scw[l0] = a0; scw[l1] = a1; scw[128 + l0] = fmaxf(pm0, mstate); scw[128 + l1] = fmaxf(pm1, mstate); scw[256 + l0] = b0; scw[256 + l1] = b1; \
            scw[384 + l0] = __expf(a0 - mx); scw[384 + l1] = __expf(a1 - mx); \
            if (lane == 0) { scw[512] = __expf(mstate - mx); scw[513] = mstate; } \
            mstate = bend + mx; } while (0)
#pragma unroll
        for (int ks = 0; ks < 8; ++ks) qn[ks] = (bf16x8){0, 0, 0, 0, 0, 0, 0, 0};
        SCAN_FETCH(0); SCAN_FETCHQ(0);
        if (wave == 0) SCAN_SCALARS(SC);
        __syncthreads();
#pragma unroll 1
        for (int step = 0; step < 34; ++step) {
            const float* sc = SC + (step & 1) * 576;
            const int r0 = STEP_R0(step);
#pragma unroll
            for (int i = 0; i < 8; ++i) { const int p = tid + 512 * i, l = p >> 5, c16 = p & 31; *(u32x4*)(KT + l * 528 + c16 * 16) = kreg[i]; }
            { const int l = tid & 127, c = tid >> 7; const float we = sc[384 + l];
                bf16_t* vt = (bf16_t*)(VT + (8 * c) * 272) + l; bf16_t* vw = (bf16_t*)(VW + (8 * c) * 272) + l;
                vt[0 * 136] = (bf16_t)(vreg.x & 0xffff); vt[1 * 136] = (bf16_t)(vreg.x >> 16); vt[2 * 136] = (bf16_t)(vreg.y & 0xffff); vt[3 * 136] = (bf16_t)(vreg.y >> 16);
                vt[4 * 136] = (bf16_t)(vreg.z & 0xffff); vt[5 * 136] = (bf16_t)(vreg.z >> 16); vt[6 * 136] = (bf16_t)(vreg.w & 0xffff); vt[7 * 136] = (bf16_t)(vreg.w >> 16);
                const unsigned w0 = pk2(bflo(vreg.x) * we, bfhi(vreg.x) * we), w1 = pk2(bflo(vreg.y) * we, bfhi(vreg.y) * we), w2 = pk2(bflo(vreg.z) * we, bfhi(vreg.z) * we), w3 = pk2(bflo(vreg.w) * we, bfhi(vreg.w) * we);
                vw[0 * 136] = (bf16_t)(w0 & 0xffff); vw[1 * 136] = (bf16_t)(w0 >> 16); vw[2 * 136] = (bf16_t)(w1 & 0xffff); vw[3 * 136] = (bf16_t)(w1 >> 16);
                vw[4 * 136] = (bf16_t)(w2 & 0xffff); vw[5 * 136] = (bf16_t)(w2 >> 16); vw[6 * 136] = (bf16_t)(w3 & 0xffff); vw[7 * 136] = (bf16_t)(w3 >> 16);
                if (c == 0) ((bf16_t*)(VW + 32 * 272))[l] = (bf16_t)(pk2(we, 0.f) & 0xffff); }
            __syncthreads();
            if (step >= 2) {
                f32x4 st[8];
#pragma unroll
                for (int kt = 0; kt < 8; ++kt) st[kt] = (f32x4){0.f, 0.f, 0.f, 0.f};
#define ST_BLOCK(kt) if ((kt) <= qt) { const unsigned char* kb_ = KT + (16 * (kt) + fr) * 528 + 16 * fq; \
                    const bf16x8 k0_ = ld_bf16x8(kb_), k1_ = ld_bf16x8(kb_ + 64), k2_ = ld_bf16x8(kb_ + 128), k3_ = ld_bf16x8(kb_ + 192), k4_ = ld_bf16x8(kb_ + 256), k5_ = ld_bf16x8(kb_ + 320), k6_ = ld_bf16x8(kb_ + 384), k7_ = ld_bf16x8(kb_ + 448); \
                    f32x4 s_ = st[kt]; \
                    s_ = __builtin_amdgcn_mfma_f32_16x16x32_bf16(k0_, qn[0], s_, 0, 0, 0); s_ = __builtin_amdgcn_mfma_f32_16x16x32_bf16(k1_, qn[1], s_, 0, 0, 0); \
                    s_ = __builtin_amdgcn_mfma_f32_16x16x32_bf16(k2_, qn[2], s_, 0, 0, 0); s_ = __builtin_amdgcn_mfma_f32_16x16x32_bf16(k3_, qn[3], s_, 0, 0, 0); \
                    s_ = __builtin_amdgcn_mfma_f32_16x16x32_bf16(k4_, qn[4], s_, 0, 0, 0); s_ = __builtin_amdgcn_mfma_f32_16x16x32_bf16(k5_, qn[5], s_, 0, 0, 0); \
                    s_ = __builtin_amdgcn_mfma_f32_16x16x32_bf16(k6_, qn[6], s_, 0, 0, 0); s_ = __builtin_amdgcn_mfma_f32_16x16x32_bf16(k7_, qn[7], s_, 0, 0, 0); st[kt] = s_; }
                ST_BLOCK(0) ST_BLOCK(1) ST_BLOCK(2) ST_BLOCK(3) ST_BLOCK(4) ST_BLOCK(5) ST_BLOCK(6) ST_BLOCK(7)
#undef ST_BLOCK
                const int q = 16 * qt + fr; const float Mqq = sc[128 + q];
                float dsum = 0.f;
#pragma unroll
                for (int kt = 0; kt < 8; ++kt) { if (kt <= qt) { const f32x4 av = *(const f32x4*)(sc + 16 * kt + 4 * fq);
#pragma unroll
                        for (int j = 0; j < 4; ++j) { const int key = 16 * kt + 4 * fq + j; const float wgt = key <= q ? __expf(av[j] - Mqq) : 0.f; st[kt][j] *= wgt; dsum += st[kt][j]; } } }
                dsum += __shfl_xor(dsum, 16); dsum += __shfl_xor(dsum, 32);
                f32x4 o1[2], cq[3];
#pragma unroll
                for (int vt = 0; vt < 2; ++vt) o1[vt] = (f32x4){0.f, 0.f, 0.f, 0.f};
#pragma unroll
                for (int vt = 0; vt < 3; ++vt) cq[vt] = (f32x4){0.f, 0.f, 0.f, 0.f};
#pragma unroll
                for (int kk = 0; kk < 4; ++kk) { if (2 * kk <= qt) {
                        u32x4 pw; pw.x = pk2(st[2 * kk][0], st[2 * kk][1]); pw.y = pk2(st[2 * kk][2], st[2 * kk][3]); pw.z = pk2(st[2 * kk + 1][0], st[2 * kk + 1][1]); pw.w = pk2(st[2 * kk + 1][2], st[2 * kk + 1][3]);
                        const bf16x8 pb = __builtin_bit_cast(bf16x8, pw);
#pragma unroll
                        for (int vt = 0; vt < 2; ++vt) { const unsigned char* vp = VT + (16 * vt + fr) * 272 + (32 * kk + 4 * fq) * 2;
                            const u32x2 lo = *(const u32x2*)vp, hi = *(const u32x2*)(vp + 32); u32x4 vw; vw.x = lo.x; vw.y = lo.y; vw.z = hi.x; vw.w = hi.y;
                            o1[vt] = __builtin_amdgcn_mfma_f32_16x16x32_bf16(__builtin_bit_cast(bf16x8, vw), pb, o1[vt], 0, 0, 0); } } }
#pragma unroll
                for (int kh = 0; kh < 2; ++kh) { bf16x8 cf[4][3];
#pragma unroll
                    for (int k4 = 0; k4 < 4; ++k4)
#pragma unroll
                        for (int vt = 0; vt < 3; ++vt) cf[k4][vt] = ld_bf16x8(CB + (16 * vt + fr) * 528 + (32 * (4 * kh + k4) + 8 * fq) * 2);
#pragma unroll
                    for (int k4 = 0; k4 < 4; ++k4)
#pragma unroll
                        for (int vt = 0; vt < 3; ++vt) cq[vt] = __builtin_amdgcn_mfma_f32_16x16x32_bf16(cf[k4][vt], qn[4 * kh + k4], cq[vt], 0, 0, 0); }
                const float nq = __shfl(cq[2][0], fr);
                const float winter = __expf(sc[513] - Mqq);
                const float den = dsum + winter * nq, flo = __expf(-sc[256 + q] - Mqq);
                const float inv = 1.0f / fmaxf(fabsf(den), flo);
                bf16_t* hp = HO + (size_t)SROWX(r0, q) * D + h * 256 + vs * 32 + 4 * fq;
#pragma unroll
                for (int vt = 0; vt < 2; ++vt) { const f32x4 hv = (o1[vt] + cq[vt] * winter) * inv; u32x2 w; w.x = pk2(hv[0], hv[1]); w.y = pk2(hv[2], hv[3]); *(u32x2*)(hp + 16 * vt) = w; }
            }
            if (step + 1 < 34) { SCAN_FETCH(step + 1); SCAN_FETCHQ(step + 1); }
            if (wave == 0 && step + 1 < 34) SCAN_SCALARS(SC + ((step + 1) & 1) * 576);
            { const float decay = sc[512];
#pragma unroll
                for (int a = 0; a < 3; ++a)
#pragma unroll
                    for (int bb = 0; bb < 2; ++bb) Cacc[a][bb] *= decay;
                const int qp = (lane & 15) >> 2, pp = lane & 3;
#pragma unroll
                for (int lh = 0; lh < 2; ++lh) {
                    bf16x8 av[2][3], bw[2][2];
#pragma unroll
                    for (int l2 = 0; l2 < 2; ++l2) { const int ls = 2 * lh + l2;
#pragma unroll
                        for (int vt = 0; vt < 3; ++vt) av[l2][vt] = ld_bf16x8(VW + (16 * vt + fr) * 272 + (32 * ls + 8 * fq) * 2);
#pragma unroll
                        for (int kdt = 0; kdt < 2; ++kdt) { const unsigned char* tp = KT + (32 * ls + 8 * fq + qp) * 528 + (16 * (2 * wave + kdt) + 4 * pp) * 2;
                            const s16x4 t0 = lds_tr16(tp), t1 = lds_tr16(tp + 4 * 528);
                            bw[l2][kdt] = (bf16x8){t0[0], t0[1], t0[2], t0[3], t1[0], t1[1], t1[2], t1[3]}; } }
#pragma unroll
                    for (int l2 = 0; l2 < 2; ++l2)
#pragma unroll
                        for (int vt = 0; vt < 3; ++vt)
#pragma unroll
                            for (int kdt = 0; kdt < 2; ++kdt) Cacc[vt][kdt] = __builtin_amdgcn_mfma_f32_16x16x32_bf16(av[l2][vt], bw[l2][kdt], Cacc[vt][kdt], 0, 0, 0);
                } }
            __syncthreads();
#pragma unroll
            for (int vt = 0; vt < 3; ++vt)
#pragma unroll
                for (int kdt = 0; kdt < 2; ++kdt)
#pragma unroll
                    for (int j = 0; j < 4; ++j) *((bf16_t*)(CB + (16 * vt + 4 * fq + j) * 528) + 32 * wave + 16 * kdt + fr) = (bf16_t)(pk2(Cacc[vt][kdt][j], 0.f) & 0xffff);
        }
#undef STEP_R0
#undef SROWX
#undef SCAN_FETCH
#undef SCAN_SCALARS
#undef SCAN_FETCHQ
    }
}
#define LAS __attribute__((address_space(3)))
#define XB_TMO      128
#define XB_XCNT(j)  (256  + 64 * (j))
#define XB_XSUB(j)  (1280 + 64 * (j))
#define XB_XGEN(j)  (2304 + 64 * (j))
#define XB_TOP      3328
#define XB_TOPGEN   3392
#define XCD_BAR_WORDS 3456
#define XB_SPIN_CAP (1u << 18)

__device__ __forceinline__ unsigned xb_ld(unsigned* p)              { return __hip_atomic_load(p, __ATOMIC_RELAXED, __HIP_MEMORY_SCOPE_AGENT); }
__device__ __forceinline__ unsigned xb_add(unsigned* p, unsigned v) { return __hip_atomic_fetch_add(p, v, __ATOMIC_RELAXED, __HIP_MEMORY_SCOPE_AGENT); }
__device__ __forceinline__ unsigned xb_xcc_id() { return (unsigned)__builtin_amdgcn_s_getreg((3 << 11) | 20) & 0xFu; }
#define XB_SPIN(cond, bar) do { unsigned _sp = 0; while (cond) { __builtin_amdgcn_s_sleep(1); \
    if ((++_sp & 255u) == 0u) { if (xb_ld(&(bar)[XB_TMO])) break; if (_sp > XB_SPIN_CAP) { atomicAdd(&(bar)[XB_TMO], 1u); break; } } } } while (0)

struct XcdBarrier {
    unsigned* bar; unsigned x;
    volatile LAS unsigned* st;
};

__device__ __forceinline__ XcdBarrier xcd_barrier_post(unsigned* bar, volatile LAS unsigned* st) {
    XcdBarrier b; b.bar = bar; b.x = xb_xcc_id(); b.st = st;
    if (threadIdx.x == 0) (void)xb_add(&bar[XB_XCNT(b.x)], 1u);
    return b;
}
__device__ __forceinline__ void xcd_barrier_complete(unsigned* bar, unsigned x, unsigned& nloc, unsigned& nx) {
    const unsigned G = gridDim.x * gridDim.y * gridDim.z;
    unsigned sum, cnt, mine, sp = 0u;
    for (;;) {
        sum = 0u; cnt = 0u; mine = 0u;
#pragma unroll
        for (unsigned j = 0; j < 16; ++j) { const unsigned c = xb_ld(&bar[XB_XCNT(j)]); sum += c; cnt += (c > 0u) ? 1u : 0u; mine = (j == x) ? c : mine; }
        if (sum == G) break;
        __builtin_amdgcn_s_sleep(1);
        if ((++sp & 255u) == 0u) { if (xb_ld(&bar[XB_TMO])) break; if (sp > XB_SPIN_CAP) { atomicAdd(&bar[XB_TMO], 1u); break; } }
    }
    nloc = mine > 0u ? mine : 1u; nx = cnt > 0u ? cnt : 1u;
}

__device__ __forceinline__ void xcd_barrier(const XcdBarrier& b) {
    asm volatile("s_waitcnt vmcnt(0)" ::: "memory");
    __syncthreads();
    if (threadIdx.x == 0) {
        unsigned* bar = b.bar;
        __builtin_amdgcn_s_waitcnt(0);
        unsigned nloc = b.st[0], nx = b.st[1];
        if (nloc == 0u) { xcd_barrier_complete(bar, b.x, nloc, nx); b.st[0] = nloc; b.st[1] = nx; }
        const unsigned old = xb_add(&bar[XB_XSUB(b.x)], 1u);
        const unsigned gen = old / nloc;
        if (old + 1u == (gen + 1u) * nloc) {
            __builtin_amdgcn_fence(__ATOMIC_RELEASE, "agent");
            asm volatile("s_waitcnt vmcnt(0)" ::: "memory");
            const unsigned og = xb_add(&bar[XB_TOP], 1u);
            const unsigned tg = og / nx;
            if (og + 1u == (tg + 1u) * nx) xb_add(&bar[XB_TOPGEN], 1u);
            else XB_SPIN(xb_ld(&bar[XB_TOPGEN]) == tg, bar);
            __builtin_amdgcn_fence(__ATOMIC_ACQUIRE, "agent");
            xb_add(&bar[XB_XGEN(b.x)], 1u);
            asm volatile("s_waitcnt vmcnt(0)" ::: "memory");
        } else {
            XB_SPIN(xb_ld(&bar[XB_XGEN(b.x)]) == gen, bar);
            __builtin_amdgcn_fence(__ATOMIC_ACQUIRE, "agent");
            asm volatile("s_waitcnt vmcnt(0)" ::: "memory");
        }
    }
    __syncthreads();
}

struct Args { const float* in[25]; float* out; unsigned char* ws; };
#define GEMM_PHASE(EPI, g, S, E) pg8::gemm_phase<EPI, pg8::Order, true, true>((PG8_LAS unsigned char*)lds, g, S, E)
__global__ void __launch_bounds__(512, 2) fwd_megakernel(Args args) {
    extern __shared__ __attribute__((aligned(16))) unsigned char lds[];
    cg::grid_group grid = cg::this_grid();
    Ctx C; C.tab = lds + LDS_BYTES - 256;
    if (threadIdx.x == 0) {
#pragma unroll
        for (int i = 0; i < 25; ++i) *(const float**)(C.tab + 8 * i) = args.in[i];
        *(float**)(C.tab + 8 * 25) = args.out; *(unsigned char**)(C.tab + 8 * 26) = args.ws; }
    if (threadIdx.x < 2) ((volatile LAS unsigned*)(lds + LDS_BYTES - 512))[threadIdx.x] = 0u;
    __syncthreads();
    const int G = gridDim.x, bid = blockIdx.x;
    (void)xcd_barrier_post((unsigned*)(args.ws + WS_BAR), (volatile LAS unsigned*)(lds + LDS_BYTES - 512));
#define GSYNC() do { XcdBarrier xb_; xb_.bar = (unsigned*)(C.ws() + WS_BAR); xb_.x = xb_xcc_id(); xb_.st = (volatile LAS unsigned*)(lds + LDS_BYTES - 512); xcd_barrier(xb_); } while (0)
#define WF(off) ((float*)(w + (off)))
#define WH(off) ((bf16_t*)(w + (off)))
    phase_p0(C, lds, G);
    if (args.ws == nullptr) grid.sync();
    GSYNC();
    phase_p0b(C, lds, G);
    GSYNC();
#pragma unroll
    for (int l = 0; l < 2; ++l) {
        const size_t mods_l = WS_MODS + (size_t)l * 5 * NMODC * 4;
        { unsigned char* w = C.ws();
          pg8::Gemm g{WH(WS_XN), WH(WS_WGU + (size_t)(l * 2 + 0) * 5632 * D * 2), M, 5632, D}; pg8::Order S; S.init(M, 5632, D, G, bid);
          pg8::EpiFFNUp E{WF(WS_RS + (size_t)(l * 3 + 0) * M * 4), WF(WS_SB + (size_t)((l * 3 + 0) * 5) * 5632 * 4), WH(WS_ACT)}; GEMM_PHASE(pg8::EpiFFNUp, g, S, E); }
        GSYNC();
        { unsigned char* w = C.ws(); float* xo = C.out();
          pg8::Gemm g{WH(WS_ACT), WH(WS_WD + (size_t)(l * 2 + 0) * D * FF * 2), M, D, FF}; pg8::Order S; S.init(ML, D, FF, G, bid, 176, 64, 0, 4, 11);
          pg8::EpiResid<1> E{l == 0 ? C.in(0) : xo, l == 0 ? C.in(2) : WF(WS_XC), xo, WF(WS_XC), WF(mods_l + 2 * D * 4), C.in(9) + l * D, WF(mods_l + 4 * D * 4), WH(WS_XN), WF(WS_RS + (size_t)(l * 3 + 1) * M * 4), WF(WS_PART)};
          GEMM_PHASE(pg8::EpiResid<1>, g, S, E); }
        GSYNC();
        { const float* bc = l == 0 ? C.in(2) : (const float*)(C.ws() + WS_XC); phase_ctx_fin<11>(C, G, 0.5f, bc, mods_l + 2 * D * 4, C.in(9) + l * D, mods_l + 4 * D * 4, WS_RS + (size_t)(l * 3 + 1) * M * 4); GSYNC(); }
        if (l == 0) {
            { unsigned char* w = C.ws();
              pg8::Gemm g{WH(WS_XN), WH(WS_WEIN), M, EVIN, D}; pg8::Order S; S.init(M, EVIN, D, G, bid);
              pg8::EpiEvenIn E{WF(WS_RS + (size_t)1 * M * 4), WF(WS_SB + (size_t)(1 * 5) * 5632 * 4), WF(WS_ROPE), WF(WS_ROPE + 4096), WH(WS_U), WH(WS_Q), WH(WS_KV)};
              GEMM_PHASE(pg8::EpiEvenIn, g, S, E); }
            GSYNC();
            phase_even_mix(C, lds, G);
            GSYNC();
        } else {
            phase_gates(C, lds, G);
            { unsigned char* w = C.ws();
              pg8::Gemm g{WH(WS_XN), WH(WS_WOIN), M, 3072, D}; pg8::Order S; S.init(ML, 3072, D, G, bid, 32, 64, 4, 8, 1);
              pg8::EpiOddIn E{WF(WS_RS + (size_t)4 * M * 4), WF(WS_SB + (size_t)(4 * 5) * 5632 * 4), WH(WS_QKV)}; GEMM_PHASE(pg8::EpiOddIn, g, S, E); }
            GSYNC();
            phase_scan(C, lds, G);
            GSYNC();
            phase_hn(C, G);
            GSYNC();
            { unsigned char* w = C.ws();
              pg8::Gemm g{WH(WS_XN), WH(WS_WOIN + (size_t)3072 * D * 2), ML, D, D}; pg8::Order S; S.init(ML, D, D, G, bid);
              pg8::EpiOddGate E{WF(WS_RS + (size_t)4 * M * 4), WF(WS_SB + (size_t)(4 * 5) * 5632 * 4), WH(WS_HN), WH(WS_MIXA_O)}; GEMM_PHASE(pg8::EpiOddGate, g, S, E); }
            GSYNC();
        }
        const int Mr = l == 0 ? M : ML;
        { unsigned char* w = C.ws(); float* xo = C.out();
          pg8::Gemm g{WH(l == 0 ? WS_MIXA_E : WS_MIXA_O), WH(l == 0 ? WS_WEOUT : WS_WOOUT), Mr, D, D}; pg8::Order S; S.init(ML, D, D, G, bid, l == 0 ? 64 : 0, 64, 0, 4, 4);
          pg8::EpiResid<2> E{xo, WF(WS_XC), xo, WF(WS_XC), WF(mods_l + 5 * D * 4), C.in(10) + l * D, WF(mods_l + 7 * D * 4), WH(WS_XN), WF(WS_RS + (size_t)(l * 3 + 2) * M * 4), l == 0 ? WF(WS_PART) : nullptr};
          GEMM_PHASE(pg8::EpiResid<2>, g, S, E); }
        GSYNC();
        if (l == 0) { phase_ctx_fin<4>(C, G, 1.0f, (const float*)(C.ws() + WS_XC), mods_l + 5 * D * 4, C.in(10) + l * D, mods_l + 7 * D * 4, WS_RS + (size_t)(l * 3 + 2) * M * 4); GSYNC(); }
        { unsigned char* w = C.ws();
          pg8::Gemm g{WH(WS_XN), WH(WS_WGU + (size_t)(l * 2 + 1) * 5632 * D * 2), Mr, 5632, D}; pg8::Order S; S.init(Mr, 5632, D, G, bid);
          pg8::EpiFFNUp E{WF(WS_RS + (size_t)(l * 3 + 2) * M * 4), WF(WS_SB + (size_t)((l * 3 + 2) * 5) * 5632 * 4), WH(WS_ACT)}; GEMM_PHASE(pg8::EpiFFNUp, g, S, E); }
        GSYNC();
        { unsigned char* w = C.ws(); float* xo = C.out();
          pg8::Gemm g{WH(WS_ACT), WH(WS_WD + (size_t)(l * 2 + 1) * D * FF * 2), Mr, D, FF}; pg8::Order S; S.init(ML, D, FF, G, bid, l == 0 ? 176 : 0, 64, 0, 4, 11);
          pg8::EpiResid<1> E{xo, WF(WS_XC), xo, WF(WS_XC), WF(mods_l + 8 * D * 4), l == 0 ? C.in(6) + D : nullptr, WF(WS_MODS + (size_t)5 * NMODC * 4 + 1 * D * 4), WH(WS_XN), WF(WS_RS + (size_t)(l == 0 ? 3 : 6) * M * 4), l == 0 ? WF(WS_PART) : nullptr};
          GEMM_PHASE(pg8::EpiResid<1>, g, S, E); }
        GSYNC();
        if (l == 0) { phase_ctx_fin<11>(C, G, 0.5f, (const float*)(C.ws() + WS_XC), mods_l + 8 * D * 4, C.in(6) + D, WS_MODS + (size_t)5 * NMODC * 4 + 1 * D * 4, WS_RS + (size_t)3 * M * 4); GSYNC(); }
    }
    phase_final(C, G);
}

extern "C" void kernel_launch(void* const* d_in, const int* in_sizes, int n_in, void* d_out, int out_size, void* d_ws, size_t ws_size, hipStream_t stream) {
    static int grid = 0;
    if (grid == 0) {
        if (n_in != 25 || ws_size < WS_END) { fprintf(stderr, "kernel_launch: unexpected n_in %d / ws_size %zu (need %zu)\n", n_in, ws_size, (size_t)WS_END); grid = -1; return; }
        int dev = 0, cus = 0, per_cu = 0;
        hipGetDevice(&dev);
        hipDeviceGetAttribute(&cus, hipDeviceAttributeMultiprocessorCount, dev);
        hipFuncSetAttribute((const void*)fwd_megakernel, hipFuncAttributeMaxDynamicSharedMemorySize, LDS_BYTES);
        if (hipOccupancyMaxActiveBlocksPerMultiprocessor(&per_cu, (const void*)fwd_megakernel, 512, LDS_BYTES) != hipSuccess || per_cu < 1) per_cu = 1;
        (void)hipGetLastError();
        grid = cus * per_cu;
    }
    if (grid < 0) return;
    (void)hipMemsetAsync(d_ws, 0, 4 * MiB, stream);
    Args a{};
    for (int i = 0; i < 25; ++i) a.in[i] = (const float*)d_in[i];
    a.out = (float*)d_out; a.ws = (unsigned char*)d_ws;
    void* kargs[] = {&a};
    hipError_t e = hipLaunchCooperativeKernel((const void*)fwd_megakernel, dim3(grid), dim3(512), kargs, LDS_BYTES, stream);
    if (e != hipSuccess) fprintf(stderr, "cooperative launch failed: %s (grid %d)\n", hipGetErrorString(e), grid);
}
```
